# Optimizing an MI355X kernel written in HIP

```python
import math, functools
import jax, jax.numpy as jnp
from jax import lax
import numpy as np

D_MODEL = 2048
BATCH = 4
SEQ = 2048
DEPTH = 1
DEC_BATCH = 8
DEC_SEQ = 1
PAST_LEN = 16384
PAGE_SIZE = 128

N_HEADS = 8
HEAD_DIM = 64
V_DIM = 2 * HEAD_DIM
ATTN_QK_WIDTH = N_HEADS * 2 * HEAD_DIM
ATTN_V_WIDTH = N_HEADS * V_DIM
SSM_WIDTH = D_MODEL // 2
SSM_GROUP = 16
N_GROUPS = SSM_WIDTH // SSM_GROUP
STATE_DIM = 64
D_FF = 5504
CONV_W = 3
NUM_BUCKETS = 32
MAX_EXACT = NUM_BUCKETS // 2
MAX_DISTANCE = 128
Q_BLOCK = 128
LN_EPS = 1e-5
NEG_INF = -1e30
Q_END = ATTN_QK_WIDTH
K_END = 2 * ATTN_QK_WIDTH
V_END = K_END + ATTN_V_WIDTH
U_END = V_END + SSM_WIDTH
GA_END = U_END + D_MODEL
IN_WIDTH = GA_END + D_MODEL

kernel_name = 'diffattn_s5_gated_convffn_deepnorm_step'


def layer_norm(x, g, b):
    xf = x.astype(jnp.float32)
    mu = jnp.mean(xf, axis=-1, keepdims=True)
    var = jnp.mean(jnp.square(xf - mu), axis=-1, keepdims=True)
    return ((xf - mu) * lax.rsqrt(var + LN_EPS) * g.astype(jnp.float32) + b.astype(jnp.float32)).astype(x.dtype)


def rms_norm(x, g):
    xf = x.astype(jnp.float32)
    return (xf * lax.rsqrt(jnp.mean(jnp.square(xf), axis=-1, keepdims=True) + LN_EPS) * g.astype(jnp.float32)).astype(x.dtype)


def rel_bucket(q_pos, k_pos):
    n = jnp.maximum(q_pos[:, None] - k_pos[None, :], 0)
    nf = jnp.maximum(n, 1).astype(jnp.float32)
    large = MAX_EXACT + (jnp.log(nf / MAX_EXACT) / math.log(MAX_DISTANCE / MAX_EXACT) * (NUM_BUCKETS - MAX_EXACT)).astype(jnp.int32)
    large = jnp.minimum(large, NUM_BUCKETS - 1)
    return jnp.where(n < MAX_EXACT, n, large)


def diff_attention(q, k, v, q_pos, k_pos, rel_bias, lam):
    s = jnp.einsum('bqhjd,bkhjd->bhjqk', q, k).astype(jnp.float32) * (HEAD_DIM ** -0.5)
    bias = jnp.transpose(rel_bias[rel_bucket(q_pos, k_pos)], (2, 0, 1)).astype(jnp.float32)
    causal = k_pos[None, :] <= q_pos[:, None]
    s = jnp.where(causal, s + bias[None, :, None], NEG_INF)
    p = jax.nn.softmax(s, axis=-1)
    p_diff = p[:, :, 0] - lam * p[:, :, 1]
    return jnp.einsum('bhqk,bkhe->bqhe', p_diff.astype(v.dtype), v)


def prompt_attention(q, k, v, rel_bias, lam):
    b, seq = q.shape[0], q.shape[1]
    n_blocks = seq // Q_BLOCK
    q_blocks = jnp.moveaxis(q.reshape(b, n_blocks, Q_BLOCK, N_HEADS, 2, HEAD_DIM), 1, 0)
    k_pos = jnp.arange(seq, dtype=jnp.int32)

    def one_block(args):
        idx, q_blk = args
        q_pos = idx * Q_BLOCK + jnp.arange(Q_BLOCK, dtype=jnp.int32)
        return diff_attention(q_blk, k, v, q_pos, k_pos, rel_bias, lam)

    out = lax.map(one_block, (jnp.arange(n_blocks, dtype=jnp.int32), q_blocks))
    return jnp.moveaxis(out, 0, 1).reshape(b, seq, N_HEADS, V_DIM)


def sample_attention(k_past, v_past, q, k, v, rel_bias, lam):
    past = k_past.shape[1]
    n_new = q.shape[1]
    k_all = jnp.concatenate([k_past.astype(k.dtype), k], axis=1)
    v_all = jnp.concatenate([v_past.astype(v.dtype), v], axis=1)
    q_pos = past + jnp.arange(n_new, dtype=jnp.int32)
    k_pos = jnp.arange(past + n_new, dtype=jnp.int32)
    return diff_attention(q, k_all, v_all, q_pos, k_pos, rel_bias, lam)


def s5_branch(u, x0_re, x0_im, a_re, a_im, log_dt, b_re, b_im, c_re, c_im, d, w_glu):
    b, seq = u.shape[0], u.shape[1]
    ug = u.reshape(b, seq, N_GROUPS, SSM_GROUP)
    dt = jnp.exp(log_dt)[:, None]
    mag = jnp.exp(a_re * dt)
    ang = a_im * dt
    abar_re = mag * jnp.cos(ang)
    abar_im = mag * jnp.sin(ang)
    den = a_re * a_re + a_im * a_im
    f_re = ((abar_re - 1.0) * a_re + abar_im * a_im) / den
    f_im = (abar_im * a_re - (abar_re - 1.0) * a_im) / den
    bb_re = f_re[..., None] * b_re - f_im[..., None] * b_im
    bb_im = f_re[..., None] * b_im + f_im[..., None] * b_re
    bu_re = jnp.einsum('blgc,gpc->blgp', ug, bb_re)
    bu_im = jnp.einsum('blgc,gpc->blgp', ug, bb_im)
    a_seq_re = jnp.broadcast_to(abar_re, bu_re.shape)
    a_seq_im = jnp.broadcast_to(abar_im, bu_im.shape)

    def combine(e1, e2):
        a1r, a1i, b1r, b1i = e1
        a2r, a2i, b2r, b2i = e2
        return (a2r * a1r - a2i * a1i,
                a2r * a1i + a2i * a1r,
                a2r * b1r - a2i * b1i + b2r,
                a2r * b1i + a2i * b1r + b2i)

    acum_re, acum_im, s_re, s_im = lax.associative_scan(combine, (a_seq_re, a_seq_im, bu_re, bu_im), axis=1)
    x_re = s_re + acum_re * x0_re[:, None] - acum_im * x0_im[:, None]
    x_im = s_im + acum_re * x0_im[:, None] + acum_im * x0_re[:, None]
    y = jnp.einsum('blgp,gcp->blgc', x_re, c_re) - jnp.einsum('blgp,gcp->blgc', x_im, c_im)
    y = y.reshape(b, seq, SSM_WIDTH) + d * u
    g = jax.nn.gelu(y)
    return g * jax.nn.sigmoid(g @ w_glu), x_re[:, -1], x_im[:, -1]


def conv_ffn(h, conv0, w_up, conv_w, conv_b, w_down):
    seq = h.shape[1]
    up = h @ w_up
    padded = jnp.concatenate([conv0.astype(up.dtype), up], axis=1)
    c = conv_b
    for j in range(CONV_W):
        c = c + conv_w[j] * padded[:, j:j + seq]
    gate, val = jnp.split(c, 2, axis=-1)
    return (jax.nn.silu(gate) * val) @ w_down, padded[:, -(CONV_W - 1):]


def decoder_layer(x, attend, ssm_re0, ssm_im0, conv0, layer_idx, rel_bias, layer_weights):
    (w_in, lambda_q1, lambda_k1, lambda_q2, lambda_k2, subln_g, ssm_a_re, ssm_a_im, ssm_log_dt,
     ssm_b_re, ssm_b_im, ssm_c_re, ssm_c_im, ssm_d, w_glu, w_proj_attn, w_proj_ssm, w_out,
     ln1_g, ln1_b, w_up, conv_w, conv_b, w_down, ln2_g, ln2_b) = layer_weights
    b, seq = x.shape[0], x.shape[1]
    alpha = (2.0 * DEPTH) ** 0.25
    lam_init = 0.8 - 0.6 * math.exp(-0.3 * layer_idx)
    z = x @ w_in
    q = z[..., :Q_END].reshape(b, seq, N_HEADS, 2, HEAD_DIM)
    k = z[..., Q_END:K_END].reshape(b, seq, N_HEADS, 2, HEAD_DIM)
    v = z[..., K_END:V_END].reshape(b, seq, N_HEADS, V_DIM)
    u = z[..., V_END:U_END]
    gate_a = jax.nn.sigmoid(z[..., U_END:GA_END])
    gate_s = jax.nn.sigmoid(z[..., GA_END:])
    lam = (jnp.exp(jnp.sum(lambda_q1.astype(jnp.float32) * lambda_k1.astype(jnp.float32)))
           - jnp.exp(jnp.sum(lambda_q2.astype(jnp.float32) * lambda_k2.astype(jnp.float32))) + lam_init)
    attn = rms_norm(attend(q, k, v, rel_bias, lam), subln_g) * (1.0 - lam_init)
    attn = attn.reshape(b, seq, ATTN_V_WIDTH)
    ssm, s_re, s_im = s5_branch(u, ssm_re0, ssm_im0, ssm_a_re, ssm_a_im, ssm_log_dt,
                                ssm_b_re, ssm_b_im, ssm_c_re, ssm_c_im, ssm_d, w_glu)
    merged = gate_a * (attn @ w_proj_attn) + gate_s * (ssm @ w_proj_ssm)
    h = layer_norm(alpha * x + merged @ w_out, ln1_g, ln1_b)
    ffn, conv_new = conv_ffn(h, conv0, w_up, conv_w, conv_b, w_down)
    y = layer_norm(alpha * h + ffn, ln2_g, ln2_b)
    return y, k, v, s_re, s_im, conv_new


def setup_inputs(seed: int = 0) -> dict:
    key = jax.random.key(seed)
    ks = jax.random.split(key, 40)
    f32 = jnp.float32
    beta = (8.0 * DEPTH) ** -0.25
    n_pages = PAST_LEN // PAGE_SIZE
    n_used = DEC_BATCH * n_pages
    n_pool = (n_used * 5) // 4

    def nrm(k, shape, scale=1.0):
        return jax.random.normal(k, shape, f32) * scale

    col_scale = jnp.concatenate([jnp.ones((K_END,), f32),
                                 jnp.full((ATTN_V_WIDTH + SSM_WIDTH,), beta, f32),
                                 jnp.ones((2 * D_MODEL,), f32)])
    page_table = jax.random.permutation(ks[5], n_pool)[:n_used].reshape(DEC_BATCH, n_pages).astype(jnp.int32)
    a_im_init = jnp.pi * jnp.arange(STATE_DIM, dtype=f32)
    return {
        'x_prompt': nrm(ks[0], (BATCH, SEQ, D_MODEL)),
        'x_sample': nrm(ks[1], (DEC_BATCH, DEC_SEQ, D_MODEL)),
        'cache_k': nrm(ks[2], (DEPTH, n_pool, PAGE_SIZE, N_HEADS, 2, HEAD_DIM)),
        'cache_v': nrm(ks[3], (DEPTH, n_pool, PAGE_SIZE, N_HEADS, V_DIM), beta),
        'state_ssm_re': nrm(ks[4], (DEPTH, DEC_BATCH, N_GROUPS, STATE_DIM), 0.3),
        'state_ssm_im': nrm(ks[6], (DEPTH, DEC_BATCH, N_GROUPS, STATE_DIM), 0.3),
        'state_conv': nrm(ks[7], (DEPTH, DEC_BATCH, CONV_W - 1, 2 * D_FF), beta),
        'page_table': page_table,
        'rel_bias': nrm(ks[8], (NUM_BUCKETS, N_HEADS), 0.5),
        'w_in': nrm(ks[9], (DEPTH, D_MODEL, IN_WIDTH), D_MODEL ** -0.5) * col_scale,
        'lambda_q1': nrm(ks[10], (DEPTH, HEAD_DIM), 0.1),
        'lambda_k1': nrm(ks[11], (DEPTH, HEAD_DIM), 0.1),
        'lambda_q2': nrm(ks[12], (DEPTH, HEAD_DIM), 0.1),
        'lambda_k2': nrm(ks[13], (DEPTH, HEAD_DIM), 0.1),
        'subln_g': 1.0 + nrm(ks[14], (DEPTH, V_DIM), 0.02),
        'ssm_a_re': -0.5 + nrm(ks[15], (DEPTH, N_GROUPS, STATE_DIM), 0.02),
        'ssm_a_im': a_im_init + nrm(ks[16], (DEPTH, N_GROUPS, STATE_DIM), 0.02),
        'ssm_log_dt': jax.random.uniform(ks[17], (DEPTH, N_GROUPS), f32, minval=math.log(1e-3), maxval=math.log(1e-1)),
        'ssm_b_re': nrm(ks[18], (DEPTH, N_GROUPS, STATE_DIM, SSM_GROUP), (2 * SSM_GROUP) ** -0.5),
        'ssm_b_im': nrm(ks[19], (DEPTH, N_GROUPS, STATE_DIM, SSM_GROUP), (2 * SSM_GROUP) ** -0.5),
        'ssm_c_re': nrm(ks[20], (DEPTH, N_GROUPS, SSM_GROUP, STATE_DIM), (2 * STATE_DIM) ** -0.5),
        'ssm_c_im': nrm(ks[21], (DEPTH, N_GROUPS, SSM_GROUP, STATE_DIM), (2 * STATE_DIM) ** -0.5),
        'ssm_d': nrm(ks[22], (DEPTH, SSM_WIDTH)),
        'w_glu': nrm(ks[23], (DEPTH, SSM_WIDTH, SSM_WIDTH), SSM_WIDTH ** -0.5),
        'w_proj_attn': nrm(ks[24], (DEPTH, ATTN_V_WIDTH, D_MODEL), beta * ATTN_V_WIDTH ** -0.5),
        'w_proj_ssm': nrm(ks[25], (DEPTH, SSM_WIDTH, D_MODEL), beta * SSM_WIDTH ** -0.5),
        'w_out': nrm(ks[26], (DEPTH, D_MODEL, D_MODEL), beta * D_MODEL ** -0.5),
        'ln1_g': 1.0 + nrm(ks[27], (DEPTH, D_MODEL), 0.02),
        'ln1_b': nrm(ks[28], (DEPTH, D_MODEL), 0.02),
        'w_up': nrm(ks[29], (DEPTH, D_MODEL, 2 * D_FF), beta * D_MODEL ** -0.5),
        'conv_w': nrm(ks[30], (DEPTH, CONV_W, 2 * D_FF), CONV_W ** -0.5),
        'conv_b': nrm(ks[31], (DEPTH, 2 * D_FF), 0.02),
        'w_down': nrm(ks[32], (DEPTH, D_FF, D_MODEL), beta * D_FF ** -0.5),
        'ln2_g': 1.0 + nrm(ks[33], (DEPTH, D_MODEL), 0.02),
        'ln2_b': nrm(ks[34], (DEPTH, D_MODEL), 0.02),
    }


def reference(x_prompt, x_sample, cache_k, cache_v, state_ssm_re, state_ssm_im, state_conv, page_table,
              rel_bias, w_in, lambda_q1, lambda_k1, lambda_q2, lambda_k2, subln_g, ssm_a_re, ssm_a_im,
              ssm_log_dt, ssm_b_re, ssm_b_im, ssm_c_re, ssm_c_im, ssm_d, w_glu, w_proj_attn, w_proj_ssm,
              w_out, ln1_g, ln1_b, w_up, conv_w, conv_b, w_down, ln2_g, ln2_b):
    bp = x_prompt.shape[0]
    bs = x_sample.shape[0]
    n_pages = page_table.shape[1]
    h_p = x_prompt
    h_s = x_sample
    kp_l, vp_l, rep_l, imp_l, cp_l = [], [], [], [], []
    ks_l, vs_l, res_l, ims_l, cs_l = [], [], [], [], []
    for l in range(DEPTH):
        lw = (w_in[l], lambda_q1[l], lambda_k1[l], lambda_q2[l], lambda_k2[l], subln_g[l], ssm_a_re[l],
              ssm_a_im[l], ssm_log_dt[l], ssm_b_re[l], ssm_b_im[l], ssm_c_re[l], ssm_c_im[l], ssm_d[l],
              w_glu[l], w_proj_attn[l], w_proj_ssm[l], w_out[l], ln1_g[l], ln1_b[l], w_up[l], conv_w[l],
              conv_b[l], w_down[l], ln2_g[l], ln2_b[l])
        zero_ssm = jnp.zeros((bp, N_GROUPS, STATE_DIM), x_prompt.dtype)
        zero_conv = jnp.zeros((bp, CONV_W - 1, 2 * D_FF), x_prompt.dtype)
        h_p, k_p, v_p, re_p, im_p, c_p = decoder_layer(h_p, prompt_attention, zero_ssm, zero_ssm, zero_conv,
                                                       l, rel_bias, lw)
        k_past = cache_k[l][page_table].reshape(bs, n_pages * PAGE_SIZE, N_HEADS, 2, HEAD_DIM)
        v_past = cache_v[l][page_table].reshape(bs, n_pages * PAGE_SIZE, N_HEADS, V_DIM)
        h_s, k_s, v_s, re_s, im_s, c_s = decoder_layer(h_s, functools.partial(sample_attention, k_past, v_past),
                                                       state_ssm_re[l], state_ssm_im[l], state_conv[l],
                                                       l, rel_bias, lw)
        kp_l.append(k_p); vp_l.append(v_p); rep_l.append(re_p); imp_l.append(im_p); cp_l.append(c_p)
        ks_l.append(k_s); vs_l.append(v_s); res_l.append(re_s); ims_l.append(im_s); cs_l.append(c_s)
    new_k_prompt = jnp.stack(kp_l, axis=0)
    new_v_prompt = jnp.stack(vp_l, axis=0)
    new_ssm_re_prompt = jnp.stack(rep_l, axis=0)
    new_ssm_im_prompt = jnp.stack(imp_l, axis=0)
    new_conv_prompt = jnp.stack(cp_l, axis=0)
    new_k_sample = jnp.stack(ks_l, axis=0)
    new_v_sample = jnp.stack(vs_l, axis=0)
    new_ssm_re_sample = jnp.stack(res_l, axis=0)
    new_ssm_im_sample = jnp.stack(ims_l, axis=0)
    new_conv_sample = jnp.stack(cs_l, axis=0)
    return (h_p, h_s, new_k_prompt, new_v_prompt, new_ssm_re_prompt, new_ssm_im_prompt, new_conv_prompt,
            new_k_sample, new_v_sample, new_ssm_re_sample, new_ssm_im_sample, new_conv_sample)
```

```cpp
#include <hip/hip_runtime.h>
#include <cstdint>
#include <cmath>
namespace gold {
constexpr int DM = 2048, NB = 4, SEQ = 2048, DB = 8, PAST = 16384, PAGE = 128, NPAGES = 128;
constexpr int NH = 8, HD = 64, VD = 128, NG = 64, SG = 16, SD = 64, DFF = 5504, DFF2 = 11008, INW = 8192;
constexpr int MP = NB * SEQ, MT = MP + DB;
constexpr float LN_EPS = 1e-5f;

__device__ const unsigned char BUCKET[128] = {0, 1, 2, 3, 4, 5, 6, 7, 8, 9, 10, 11, 12, 13, 14, 15, 16, 16, 16, 17, 17, 18, 18, 18, 19, 19, 19, 20, 20, 20, 20, 21, 21, 21, 21, 22, 22, 22, 22, 22, 23, 23, 23, 23, 23, 23, 24, 24, 24, 24, 24, 24, 25, 25, 25, 25, 25, 25, 25, 26, 26, 26, 26, 26, 26, 26, 26, 27, 27, 27, 27, 27, 27, 27, 27, 27, 27, 28, 28, 28, 28, 28, 28, 28, 28, 28, 28, 29, 29, 29, 29, 29, 29, 29, 29, 29, 29, 29, 29, 30, 30, 30, 30, 30, 30, 30, 30, 30, 30, 30, 30, 30, 30, 31, 31, 31, 31, 31, 31, 31, 31, 31, 31, 31, 31, 31, 31, 31};

__device__ __forceinline__ float sigmoidf_(float x) { return 1.f / (1.f + expf(-x)); }
__device__ __forceinline__ float gelu_tanh(float x) { return 0.5f * x * (1.f + tanhf(0.7978845608028654f * (x + 0.044715f * x * x * x))); }

__global__ void k_concat_x(const float* xp, const float* xs, float* xall) {
    size_t i = (size_t)blockIdx.x * blockDim.x + threadIdx.x, n = (size_t)MT * DM, st = (size_t)gridDim.x * blockDim.x;
    for (; i < n; i += st) xall[i] = i < (size_t)MP * DM ? xp[i] : xs[i - (size_t)MP * DM];
}
__global__ void k_lam(const float* q1, const float* k1, const float* q2, const float* k2, float* lam) {
    if (threadIdx.x == 0 && blockIdx.x == 0) { float a = 0.f, b = 0.f; for (int i = 0; i < 64; ++i) { a += q1[i] * k1[i]; b += q2[i] * k2[i]; } lam[0] = expf(a) - expf(b) + 0.2f; }
}

struct Epi { float* out; int ldo; const float* a1; int ld1; int off1; const float* a2; int ld2; int off2; float alpha; };
template <int MODE>
__global__ void __launch_bounds__(256) g_gemm(const float* __restrict__ A, int lda, const float* __restrict__ W, int M, int N, int K, Epi e) {
    __shared__ float As[16][68];
    __shared__ float Ws[16][64];
    const int tid = threadIdx.x, tx = tid & 15, ty = tid >> 4;
    const int m0 = blockIdx.y * 64, n0 = blockIdx.x * 64;
    float acc[4][4];
#pragma unroll
    for (int i = 0; i < 4; ++i)
#pragma unroll
        for (int j = 0; j < 4; ++j) acc[i][j] = 0.f;
    for (int k0 = 0; k0 < K; k0 += 16) {
        { const int r = tid >> 2, kk = (tid & 3) * 4, gr = m0 + r;
          float4 v = make_float4(0.f, 0.f, 0.f, 0.f); if (gr < M) v = *(const float4*)(A + (size_t)gr * lda + k0 + kk);
          As[kk][r] = v.x; As[kk + 1][r] = v.y; As[kk + 2][r] = v.z; As[kk + 3][r] = v.w; }
        { const int kk = tid >> 4, c = (tid & 15) * 4; *(float4*)&Ws[kk][c] = *(const float4*)(W + (size_t)(k0 + kk) * N + n0 + c); }
        __syncthreads();
#pragma unroll
        for (int kk = 0; kk < 16; ++kk) {
            const float4 a = *(const float4*)&As[kk][ty * 4]; const float4 b = *(const float4*)&Ws[kk][tx * 4];
            const float av[4] = {a.x, a.y, a.z, a.w}, bv[4] = {b.x, b.y, b.z, b.w};
#pragma unroll
            for (int i = 0; i < 4; ++i)
#pragma unroll
                for (int j = 0; j < 4; ++j) acc[i][j] += av[i] * bv[j];
        }
        __syncthreads();
    }
#pragma unroll
    for (int i = 0; i < 4; ++i) { const int row = m0 + ty * 4 + i; if (row >= M) continue;
#pragma unroll
        for (int j = 0; j < 4; ++j) { const int col = n0 + tx * 4 + j; const float a = acc[i][j]; float o;
            if (MODE == 0) o = a;
            else if (MODE == 1) o = e.a1[(size_t)row * e.ld1 + col] * sigmoidf_(a);
            else if (MODE == 2) o = sigmoidf_(e.a1[(size_t)row * e.ld1 + e.off1 + col]) * a;
            else if (MODE == 3) o = e.a2[(size_t)row * e.ld2 + col] + sigmoidf_(e.a1[(size_t)row * e.ld1 + e.off1 + col]) * a;
            else o = e.alpha * e.a1[(size_t)row * e.ld1 + col] + a;
            e.out[(size_t)row * e.ldo + col] = o; } }
}

__global__ void k_kv_out(const float* Z, float* kp, float* vp, float* ks, float* vs) {
    size_t i = (size_t)blockIdx.x * blockDim.x + threadIdx.x, n = (size_t)MT * 1024, st = (size_t)gridDim.x * blockDim.x;
    for (; i < n; i += st) { const int row = (int)(i / 1024), c = (int)(i % 1024); const float k = Z[(size_t)row * INW + 1024 + c], v = Z[(size_t)row * INW + 2048 + c];
        if (row < MP) { kp[(size_t)row * 1024 + c] = k; vp[(size_t)row * 1024 + c] = v; } else { ks[(size_t)(row - MP) * 1024 + c] = k; vs[(size_t)(row - MP) * 1024 + c] = v; } }
}

constexpr int ACH = 512;
__global__ void __launch_bounds__(128) k_attn(const float* __restrict__ Z, const float* __restrict__ ck, const float* __restrict__ cv, const int* __restrict__ pt, const float* __restrict__ relb, float* O0, float* O1) {
    __shared__ float sq[64]; __shared__ float sc[ACH]; __shared__ float red[128];
    const int row = blockIdx.x, hj = blockIdx.y, h = hj >> 1, j = hj & 1, tid = threadIdx.x;
    const bool samp = row >= MP; const int b = samp ? row - MP : row / SEQ, t = samp ? PAST : row % SEQ; const int nk = t + 1;
    if (tid < 64) sq[tid] = Z[(size_t)row * INW + hj * 64 + tid];
    __syncthreads();
    float m_run = -INFINITY, l_run = 0.f, o = 0.f;
    for (int k0 = 0; k0 < nk; k0 += ACH) {
        const int cn = (nk - k0) < ACH ? (nk - k0) : ACH;
        float lmax = -INFINITY;
        for (int i = tid; i < cn; i += 128) { const int key = k0 + i; const float* kp;
            if (!samp) kp = Z + (size_t)(b * SEQ + key) * INW + 1024 + hj * 64;
            else if (key < PAST) kp = ck + ((size_t)pt[b * NPAGES + key / PAGE] * PAGE + key % PAGE) * 1024 + hj * 64;
            else kp = Z + (size_t)row * INW + 1024 + hj * 64;
            float s = 0.f;
#pragma unroll 16
            for (int d = 0; d < 64; ++d) s += sq[d] * kp[d];
            const int n = t - key; const int bk = n < 128 ? BUCKET[n] : 31;
            s = s * 0.125f + relb[bk * NH + h]; sc[i] = s; lmax = fmaxf(lmax, s); }
        red[tid] = lmax; __syncthreads();
        for (int s_ = 64; s_ > 0; s_ >>= 1) { if (tid < s_) red[tid] = fmaxf(red[tid], red[tid + s_]); __syncthreads(); }
        const float m_new = fmaxf(m_run, red[0]); __syncthreads();
        float lsum = 0.f;
        for (int i = tid; i < cn; i += 128) { const float p = expf(sc[i] - m_new); sc[i] = p; lsum += p; }
        red[tid] = lsum; __syncthreads();
        for (int s_ = 64; s_ > 0; s_ >>= 1) { if (tid < s_) red[tid] += red[tid + s_]; __syncthreads(); }
        const float scale = expf(m_run - m_new);
        l_run = l_run * scale + red[0]; o *= scale; m_run = m_new;
        for (int i = 0; i < cn; ++i) { const int key = k0 + i; const float* vp;
            if (!samp) vp = Z + (size_t)(b * SEQ + key) * INW + 2048 + h * 128;
            else if (key < PAST) vp = cv + ((size_t)pt[b * NPAGES + key / PAGE] * PAGE + key % PAGE) * 1024 + h * 128;
            else vp = Z + (size_t)row * INW + 2048 + h * 128;
            o += sc[i] * vp[tid]; }
        __syncthreads();
    }
    (j ? O1 : O0)[(size_t)row * 1024 + h * 128 + tid] = o / l_run;
}
__global__ void __launch_bounds__(128) k_attn_comb(const float* O0, const float* O1, const float* lam, const float* g, float* ATT) {
    __shared__ float red[128];
    const int row = blockIdx.x, h = blockIdx.y, tid = threadIdx.x; const size_t ix = (size_t)row * 1024 + h * 128 + tid;
    const float v = O0[ix] - lam[0] * O1[ix];
    red[tid] = v * v; __syncthreads();
    for (int s_ = 64; s_ > 0; s_ >>= 1) { if (tid < s_) red[tid] += red[tid + s_]; __syncthreads(); }
    ATT[ix] = v * rsqrtf(red[0] * (1.f / 128.f) + LN_EPS) * g[tid] * 0.8f;
}
__global__ void __launch_bounds__(64) k_s5_scan(const float* __restrict__ Z, const float* a_re, const float* a_im, const float* log_dt, const float* b_re, const float* b_im,
                                                const float* st_re, const float* st_im, float* XRE, float* XIM, float* o_re_p, float* o_im_p, float* o_re_s, float* o_im_s) {
    const int g = blockIdx.x, bb_ = blockIdx.y, p = threadIdx.x; const bool samp = bb_ >= NB; const int b = samp ? bb_ - NB : bb_;
    const float dt = expf(log_dt[g]), ar = a_re[g * 64 + p], ai = a_im[g * 64 + p];
    const float mag = expf(ar * dt), ang = ai * dt, abr = mag * cosf(ang), abi = mag * sinf(ang);
    const float den = ar * ar + ai * ai, fr = ((abr - 1.f) * ar + abi * ai) / den, fi = (abi * ar - (abr - 1.f) * ai) / den;
    float bbr[16], bbi[16];
#pragma unroll
    for (int c = 0; c < 16; ++c) { const float br = b_re[(g * 64 + p) * 16 + c], bi = b_im[(g * 64 + p) * 16 + c]; bbr[c] = fr * br - fi * bi; bbi[c] = fr * bi + fi * br; }
    float xr = 0.f, xi = 0.f; int L = SEQ, row0 = b * SEQ;
    if (samp) { xr = st_re[(b * NG + g) * 64 + p]; xi = st_im[(b * NG + g) * 64 + p]; L = 1; row0 = MP + b; }
    for (int t = 0; t < L; ++t) { const float* u = Z + (size_t)(row0 + t) * INW + 3072 + g * 16; float br = 0.f, bi = 0.f;
#pragma unroll
        for (int c = 0; c < 16; ++c) { const float uc = u[c]; br += bbr[c] * uc; bi += bbi[c] * uc; }
        const float nr = abr * xr - abi * xi + br, ni = abr * xi + abi * xr + bi; xr = nr; xi = ni;
        XRE[(size_t)(row0 + t) * 4096 + g * 64 + p] = xr; XIM[(size_t)(row0 + t) * 4096 + g * 64 + p] = xi; }
    if (samp) { o_re_s[(b * NG + g) * 64 + p] = xr; o_im_s[(b * NG + g) * 64 + p] = xi; } else { o_re_p[(b * NG + g) * 64 + p] = xr; o_im_p[(b * NG + g) * 64 + p] = xi; }
}
__global__ void k_s5_out(const float* __restrict__ Z, const float* XRE, const float* XIM, const float* c_re, const float* c_im, const float* d, float* G) {
    size_t i = (size_t)blockIdx.x * blockDim.x + threadIdx.x; if (i >= (size_t)MT * 1024) return;
    const int row = (int)(i / 1024), ch = (int)(i % 1024), g = ch / 16, c = ch % 16; float y = 0.f;
    const float* xr = XRE + (size_t)row * 4096 + g * 64; const float* xi = XIM + (size_t)row * 4096 + g * 64; const float* cr = c_re + (g * 16 + c) * 64; const float* ci = c_im + (g * 16 + c) * 64;
    for (int p = 0; p < 64; ++p) y += xr[p] * cr[p] - xi[p] * ci[p];
    y += d[ch] * Z[(size_t)row * INW + 3072 + ch];
    G[i] = gelu_tanh(y);
}
__global__ void __launch_bounds__(256) k_ln(const float* S, const float* g, const float* b, float* out, float* out_s, int split_row) {
    __shared__ float red[256];
    const int row = blockIdx.x, tid = threadIdx.x; const float* x = S + (size_t)row * DM; float v[8]; float s = 0.f;
#pragma unroll
    for (int i = 0; i < 8; ++i) { v[i] = x[tid + 256 * i]; s += v[i]; }
    red[tid] = s; __syncthreads();
    for (int s_ = 128; s_ > 0; s_ >>= 1) { if (tid < s_) red[tid] += red[tid + s_]; __syncthreads(); }
    const float mu = red[0] * (1.f / DM); __syncthreads(); float q = 0.f;
#pragma unroll
    for (int i = 0; i < 8; ++i) { v[i] -= mu; q += v[i] * v[i]; }
    red[tid] = q; __syncthreads();
    for (int s_ = 128; s_ > 0; s_ >>= 1) { if (tid < s_) red[tid] += red[tid + s_]; __syncthreads(); }
    const float rstd = rsqrtf(red[0] * (1.f / DM) + LN_EPS);
    float* o = (row < split_row) ? out + (size_t)row * DM : out_s + (size_t)(row - split_row) * DM;
#pragma unroll
    for (int i = 0; i < 8; ++i) { const int c = tid + 256 * i; o[c] = v[i] * rstd * g[c] + b[c]; }
}
__global__ void k_conv(const float* __restrict__ UP, const float* cw, const float* cb, const float* st_conv, float* ACT, float* ncp, float* ncs) {
    size_t i = (size_t)blockIdx.x * blockDim.x + threadIdx.x; if (i >= (size_t)MT * DFF) return;
    const int row = (int)(i / DFF), c = (int)(i % DFF); const bool samp = row >= MP; float r[2];
#pragma unroll
    for (int hh = 0; hh < 2; ++hh) { const int ch = c + hh * DFF; float p1, p2; const float cur = UP[(size_t)row * DFF2 + ch];
        if (samp) { const int b = row - MP; p2 = st_conv[(size_t)(b * 2 + 0) * DFF2 + ch]; p1 = st_conv[(size_t)(b * 2 + 1) * DFF2 + ch];
            ncs[(size_t)(b * 2 + 0) * DFF2 + ch] = p1; ncs[(size_t)(b * 2 + 1) * DFF2 + ch] = cur; }
        else { const int t = row % SEQ, b = row / SEQ; p1 = t >= 1 ? UP[(size_t)(row - 1) * DFF2 + ch] : 0.f; p2 = t >= 2 ? UP[(size_t)(row - 2) * DFF2 + ch] : 0.f;
            if (t >= SEQ - 2) ncp[(size_t)(b * 2 + (t - (SEQ - 2))) * DFF2 + ch] = cur; }
        r[hh] = cb[ch] + cw[ch] * p2 + cw[DFF2 + ch] * p1 + cw[2 * DFF2 + ch] * cur; }
    ACT[i] = r[0] * sigmoidf_(r[0]) * r[1];
}
}
struct Bump { char* base; size_t off; template <class T> T* take(size_t n) { T* p = (T*)(base + off); off += (n * sizeof(T) + 255) & ~(size_t)255; return p; } };
extern "C" void kernel_launch(void* const* d_in, const int* in_sizes, int n_in, void* d_out, int out_size, void* d_ws, size_t ws_size, hipStream_t stream) {
    using namespace gold;
    const float* x_prompt = (const float*)d_in[0]; const float* x_sample = (const float*)d_in[1]; const float* cache_k = (const float*)d_in[2]; const float* cache_v = (const float*)d_in[3];
    const float* st_re = (const float*)d_in[4]; const float* st_im = (const float*)d_in[5]; const float* st_conv = (const float*)d_in[6]; const int* page_table = (const int*)d_in[7];
    const float* rel_bias = (const float*)d_in[8]; const float* w_in = (const float*)d_in[9];
    const float* lq1 = (const float*)d_in[10]; const float* lk1 = (const float*)d_in[11]; const float* lq2 = (const float*)d_in[12]; const float* lk2 = (const float*)d_in[13];
    const float* subln_g = (const float*)d_in[14]; const float* a_re = (const float*)d_in[15]; const float* a_im = (const float*)d_in[16]; const float* log_dt = (const float*)d_in[17];
    const float* b_re = (const float*)d_in[18]; const float* b_im = (const float*)d_in[19]; const float* c_re = (const float*)d_in[20]; const float* c_im = (const float*)d_in[21];
    const float* ssm_d = (const float*)d_in[22]; const float* w_glu = (const float*)d_in[23]; const float* w_pa = (const float*)d_in[24]; const float* w_ps = (const float*)d_in[25];
    const float* w_out = (const float*)d_in[26]; const float* ln1_g = (const float*)d_in[27]; const float* ln1_b = (const float*)d_in[28]; const float* w_up = (const float*)d_in[29];
    const float* conv_w = (const float*)d_in[30]; const float* conv_b = (const float*)d_in[31]; const float* w_down = (const float*)d_in[32]; const float* ln2_g = (const float*)d_in[33]; const float* ln2_b = (const float*)d_in[34];
    float* out = (float*)d_out;
    float* o_yp = out; float* o_ys = o_yp + (size_t)MP * DM; float* o_kp = o_ys + (size_t)DB * DM; float* o_vp = o_kp + (size_t)MP * 1024; float* o_rep = o_vp + (size_t)MP * 1024;
    float* o_imp = o_rep + NB * 4096; float* o_cp = o_imp + NB * 4096; float* o_ks = o_cp + (size_t)NB * 2 * DFF2; float* o_vs = o_ks + DB * 1024; float* o_res = o_vs + DB * 1024;
    float* o_ims = o_res + DB * 4096; float* o_cs = o_ims + DB * 4096;
    Bump B{(char*)d_ws, 0};
    float* lam = B.take<float>(64); float* Xall = B.take<float>((size_t)MT * DM); float* Z = B.take<float>((size_t)MT * INW);
    float* O0 = B.take<float>((size_t)MT * 1024); float* O1 = B.take<float>((size_t)MT * 1024); float* ATT = B.take<float>((size_t)MT * 1024);
    float* XRE = B.take<float>((size_t)MT * 4096); float* XIM = B.take<float>((size_t)MT * 4096); float* G = B.take<float>((size_t)MT * 1024); float* SSM = B.take<float>((size_t)MT * 1024);
    float* MA = B.take<float>((size_t)MT * DM); float* MG = B.take<float>((size_t)MT * DM); float* S1 = B.take<float>((size_t)MT * DM); float* Hf = B.take<float>((size_t)MT * DM);
    float* UP = B.take<float>((size_t)MT * DFF2); float* ACT = B.take<float>((size_t)MT * DFF); float* S2 = B.take<float>((size_t)MT * DM);
    const int MTt = (MT + 63) / 64; const float alpha = 1.189207115002721f;
    hipLaunchKernelGGL(k_concat_x, dim3(2048), dim3(256), 0, stream, x_prompt, x_sample, Xall);
    hipLaunchKernelGGL(k_lam, dim3(1), dim3(64), 0, stream, lq1, lk1, lq2, lk2, lam);
    { Epi e{Z, INW, nullptr, 0, 0, nullptr, 0, 0, 0.f}; hipLaunchKernelGGL(g_gemm<0>, dim3(INW / 64, MTt), dim3(256), 0, stream, Xall, DM, w_in, MT, INW, DM, e); }
    hipLaunchKernelGGL(k_kv_out, dim3(2048), dim3(256), 0, stream, Z, o_kp, o_vp, o_ks, o_vs);
    hipLaunchKernelGGL(k_attn, dim3(MT, 16), dim3(128), 0, stream, Z, cache_k, cache_v, page_table, rel_bias, O0, O1);
    hipLaunchKernelGGL(k_attn_comb, dim3(MT, NH), dim3(128), 0, stream, O0, O1, lam, subln_g, ATT);
    hipLaunchKernelGGL(k_s5_scan, dim3(NG, NB + DB), dim3(64), 0, stream, Z, a_re, a_im, log_dt, b_re, b_im, st_re, st_im, XRE, XIM, o_rep, o_imp, o_res, o_ims);
    hipLaunchKernelGGL(k_s5_out, dim3((MT * 1024 + 255) / 256), dim3(256), 0, stream, Z, XRE, XIM, c_re, c_im, ssm_d, G);
    { Epi e{SSM, 1024, G, 1024, 0, nullptr, 0, 0, 0.f}; hipLaunchKernelGGL(g_gemm<1>, dim3(1024 / 64, MTt), dim3(256), 0, stream, G, 1024, w_glu, MT, 1024, 1024, e); }
    { Epi e{MA, DM, Z, INW, 4096, nullptr, 0, 0, 0.f}; hipLaunchKernelGGL(g_gemm<2>, dim3(DM / 64, MTt), dim3(256), 0, stream, ATT, 1024, w_pa, MT, DM, 1024, e); }
    { Epi e{MG, DM, Z, INW, 6144, MA, DM, 0, 0.f}; hipLaunchKernelGGL(g_gemm<3>, dim3(DM / 64, MTt), dim3(256), 0, stream, SSM, 1024, w_ps, MT, DM, 1024, e); }
    { Epi e{S1, DM, Xall, DM, 0, nullptr, 0, 0, alpha}; hipLaunchKernelGGL(g_gemm<4>, dim3(DM / 64, MTt), dim3(256), 0, stream, MG, DM, w_out, MT, DM, DM, e); }
    hipLaunchKernelGGL(k_ln, dim3(MT), dim3(256), 0, stream, S1, ln1_g, ln1_b, Hf, Hf + (size_t)MP * DM, MP);
    { Epi e{UP, DFF2, nullptr, 0, 0, nullptr, 0, 0, 0.f}; hipLaunchKernelGGL(g_gemm<0>, dim3(DFF2 / 64, MTt), dim3(256), 0, stream, Hf, DM, w_up, MT, DFF2, DM, e); }
    hipLaunchKernelGGL(k_conv, dim3((unsigned)(((size_t)MT * DFF + 255) / 256)), dim3(256), 0, stream, UP, conv_w, conv_b, st_conv, ACT, o_cp, o_cs);
    { Epi e{S2, DM, Hf, DM, 0, nullptr, 0, 0, alpha}; hipLaunchKernelGGL(g_gemm<4>, dim3(DM / 64, MTt), dim3(256), 0, stream, ACT, DFF, w_down, MT, DM, DFF, e); }
    hipLaunchKernelGGL(k_ln, dim3(MT), dim3(256), 0, stream, S2, ln2_g, ln2_b, o_yp, o_ys, MP);
}
```

```cpp
#define MK_DEBUG 0
#define MK_ONE_LAUNCH 1
#define MAGA 0
#define MAGB 0
#define NOBIAS 0
#define ATT_ORIG 4
#include <hip/hip_runtime.h>
#include <hip/hip_bf16.h>
#include <cstdio>
#include <cstdint>
#include <cmath>
namespace pg8 {
#define PG8_LAS __attribute__((address_space(3)))
typedef unsigned short bf16_t;
typedef short bf16x8 __attribute__((ext_vector_type(8)));
typedef float f32x4 __attribute__((ext_vector_type(4)));
typedef unsigned u32x4 __attribute__((ext_vector_type(4)));
constexpr int BM = 256, BK = 64, HALF = 128, HTB = HALF * BK * 2  , STAGE_BYTES = 8 * HTB, NXCD = 8, WGM = 8;

__host__ __device__ __forceinline__ int lds_byte(int r, int c) { const int st = (r >> 4) * 2 + (c >> 5), rr = r & 15, cc = c & 31, ob = rr * 64 + cc * 2; return st * 1024 + (ob ^ (((ob >> 9) & 1) << 5)); }
__host__ __device__ __forceinline__ void stage_rc(int b, int& R, int& C) { const int st = b / 1024, sb = b % 1024, swz = sb ^ (((sb >> 9) & 1) << 5); R = (st >> 1) * 16 + swz / 64; C = (st & 1) * 32 + (swz % 64) / 2; }
__host__ __device__ __forceinline__ int perm32(int rho) { const int n = rho >> 4, i = rho & 15; return 8 * (i >> 2) + 4 * n + (i & 3); }

struct Unit { int pm, pn; };
struct Gemm { const bf16_t* A; const bf16_t* Bt; int M, N, K; };

struct StaticOrder {
    int nM, nN, nwg, G, c;
    __host__ __device__ void init(int M, int N, int G_, int c_) { nM = M / BM; nN = N / BM; nwg = nM * nN; G = G_; c = c_; }
    __host__ __device__ bool next(int i, Unit& u) const {
        const long L = (long)i * G + c; if (L >= nwg) return false;
        int wgid = (int)L; { const int q = nwg / NXCD, r = nwg % NXCD, xcd = wgid % NXCD, off = wgid / NXCD; wgid = (xcd < r ? xcd * (q + 1) : r * (q + 1) + (xcd - r) * q) + off; }
        const int nig = WGM * nN, gid = wgid / nig, fm = gid * WGM, gsz = (nM - fm) < WGM ? (nM - fm) : WGM;
        u.pm = fm + ((wgid % nig) % gsz); u.pn = (wgid % nig) / gsz; return true;
    }
    __device__ __forceinline__ void a_ready(const Unit&) const {}
    __device__ __forceinline__ void done(const Unit&) const {}
};

__device__ __forceinline__ unsigned cvt_pk_bf16(float lo, float hi) { unsigned r; asm volatile("v_cvt_pk_bf16_f32 %0, %1, %2" : "=v"(r) : "v"(lo), "v"(hi)); return r; }
typedef float f32x2 __attribute__((ext_vector_type(2)));
__device__ __forceinline__ f32x2 gelu_pk(f32x2 v) {
    const f32x2 av = __builtin_elementwise_abs(v), d = av * 0.2316418882f + 1.0f;
    f32x2 t; t.x = __builtin_amdgcn_rcpf(d.x); t.y = __builtin_amdgcn_rcpf(d.y);
    f32x2 q = t * 0.5307027145f + (-0.7265760135f); q = q * t + 0.7107068705f; q = q * t + (-0.142248368f); q = q * t + 0.127414796f; q = q * t;
    const f32x2 s = (v * v) * (-0.72134752044f);
    f32x2 e; e.x = __builtin_amdgcn_exp2f(s.x); e.y = __builtin_amdgcn_exp2f(s.y);
    const f32x2 m = v * (q * e), r = v - m;
    f32x2 o; o.x = v.x < 0.f ? m.x : r.x; o.y = v.y < 0.f ? m.y : r.y; return o;
}

template <int ACT  > struct EpiBf16 {
    static constexpr bool PERM = true, AFTER_DRAIN = false; static_assert(ACT == 0 || ACT == 1, "EpiBf16: ACT is 0 (none) or 1 (gelu_pk)");
    bf16_t* O; int ldc; const float* bias; int split_cols; size_t split_stride; float scale0;
    __device__ __forceinline__ void operator()(const f32x4 (&acc)[2][2][4][2], const Unit& u, int wr, int wc, int fr, int fq) const {
        const int row0 = u.pm * BM + wr * 64 + fr; int colt = u.pn * BM; bf16_t* base = O;
        float sc = 1.f; if (split_cols) { const int t = colt / split_cols; base += (size_t)t * split_stride; colt -= t * split_cols; if (t == 0) sc = scale0; }
        const int col0 = colt + wc * 32 + 8 * fq, bcol0 = u.pn * BM + wc * 32 + 8 * fq;
        f32x4 bv[2][2];
#pragma unroll
        for (int bj = 0; bj < 2; ++bj)
#pragma unroll
            for (int n = 0; n < 2; ++n) bv[bj][n] = bias ? *(const f32x4*)(bias + bcol0 + bj * HALF + 4 * n) : (f32x4){0.f, 0.f, 0.f, 0.f};
#pragma unroll
        for (int ai = 0; ai < 2; ++ai)
#pragma unroll
            for (int m = 0; m < 4; ++m) { bf16_t* rowp = base + (size_t)(row0 + ai * HALF + m * 16) * ldc + col0;
#pragma unroll
                for (int bj = 0; bj < 2; ++bj) { f32x4 v0 = acc[ai][bj][m][0] + bv[bj][0], v1 = acc[ai][bj][m][1] + bv[bj][1];
                    if (ACT == 1) { f32x2 a = gelu_pk((f32x2){v0[0], v0[1]}), b = gelu_pk((f32x2){v0[2], v0[3]}), c = gelu_pk((f32x2){v1[0], v1[1]}), d = gelu_pk((f32x2){v1[2], v1[3]});
                        v0 = (f32x4){a.x, a.y, b.x, b.y}; v1 = (f32x4){c.x, c.y, d.x, d.y}; }
                    v0 = v0 * sc; v1 = v1 * sc; u32x4 w; w.x = cvt_pk_bf16(v0[0], v0[1]); w.y = cvt_pk_bf16(v0[2], v0[3]); w.z = cvt_pk_bf16(v1[0], v1[1]); w.w = cvt_pk_bf16(v1[2], v1[3]);
                    *(u32x4*)(rowp + bj * HALF) = w; } }
    }
};

struct PanelStats {
    unsigned* xbuf;
    unsigned* cnt;
    unsigned* tmo;
    int ntn; float eps;
    unsigned code;
    __device__ __forceinline__ bool run(const f32x4 (&v)[2][2][4][2], const Unit& u, int wr, int wc, int fr, int fq, PG8_LAS unsigned char* lds, int wid, int lane) const {
        typedef float f32x2v __attribute__((ext_vector_type(2)));
        PG8_LAS f32x2v* P = (PG8_LAS f32x2v*)lds;
        PG8_LAS f32x2v* S = (PG8_LAS f32x2v*)(lds + 8192);
        PG8_LAS unsigned* flag = (PG8_LAS unsigned*)(lds + 8192 + 2048);
#pragma unroll
        for (int ai = 0; ai < 2; ++ai)
#pragma unroll
            for (int m = 0; m < 4; ++m) {
                float s = 0.f;
#pragma unroll
                for (int bj = 0; bj < 2; ++bj)
#pragma unroll
                    for (int n = 0; n < 2; ++n) { const f32x4 x = v[ai][bj][m][n]; s += (x[0] + x[1]) + (x[2] + x[3]); }
                s += __shfl_xor(s, 16); s += __shfl_xor(s, 32);
                const float mw = s * (1.0f / 64.0f); float q = 0.f;
#pragma unroll
                for (int bj = 0; bj < 2; ++bj)
#pragma unroll
                    for (int n = 0; n < 2; ++n) { const f32x4 d = v[ai][bj][m][n] - mw; q += (d[0] * d[0] + d[1] * d[1]) + (d[2] * d[2] + d[3] * d[3]); }
                q += __shfl_xor(q, 16); q += __shfl_xor(q, 32);
                if (fq == 0) P[(ai * HALF + wr * 64 + m * 16 + fr) * 4 + wc] = (f32x2v){mw, q};
            }
        asm volatile("s_waitcnt lgkmcnt(0)" ::: "memory"); __builtin_amdgcn_s_barrier(); asm volatile("" ::: "memory");
#if defined(BROKEN_EXCHANGE_NO_WAIT)
#warning BROKEN CONTROL BUILD: the row-statistics exchange does not wait; results are wrong by design
        if (blockIdx.x >= 64) { const long long t0_ = clock64(); while (clock64() - t0_ < 60000) __builtin_amdgcn_s_sleep(8); }
#endif
        const int row = wid * 32 + (lane & 31);
        if (lane < 32) {
            const f32x2v a = P[row * 4 + 0], b = P[row * 4 + 1], c = P[row * 4 + 2], d = P[row * 4 + 3];
            const float mt = (a.x + b.x + c.x + d.x) * 0.25f;
            const float da = a.x - mt, db = b.x - mt, dc = c.x - mt, dd = d.x - mt;
            const float m2 = (a.y + b.y) + (c.y + d.y) + 64.0f * ((da * da + db * db) + (dc * dc + dd * dd));
            unsigned long long* slot = (unsigned long long*)xbuf + ((size_t)(u.pm * BM + row) * 4 + u.pn);
            __hip_atomic_store(slot, ((unsigned long long)__float_as_uint(m2) << 32) | __float_as_uint(mt), __ATOMIC_RELAXED, __HIP_MEMORY_SCOPE_AGENT);
        }
        asm volatile("s_waitcnt vmcnt(0)" ::: "memory");
        if (lane == 0) __hip_atomic_fetch_add(cnt + 64 * u.pm, 1u, __ATOMIC_RELAXED, __HIP_MEMORY_SCOPE_AGENT);
        if (wid == 0) {
            bool dead = false; const unsigned long long t0 = __builtin_amdgcn_s_memrealtime(); const unsigned want = 8u * (unsigned)ntn;
            for (;;) {
#if defined(BROKEN_EXCHANGE_NO_WAIT)
                break;
#endif
                if ((unsigned)__builtin_amdgcn_readfirstlane(__hip_atomic_load(cnt + 64 * u.pm, __ATOMIC_RELAXED, __HIP_MEMORY_SCOPE_AGENT)) >= want) break;
                if (__builtin_amdgcn_s_memrealtime() - t0 > 2000000ull) {
                    if (lane == 0) { unsigned expect = 0u; __hip_atomic_compare_exchange_strong(tmo + 1, &expect, code | (unsigned)(u.pm & 0xff), __ATOMIC_RELAXED, __ATOMIC_RELAXED, __HIP_MEMORY_SCOPE_AGENT);
                                     __hip_atomic_store(tmo, 1u, __ATOMIC_RELAXED, __HIP_MEMORY_SCOPE_AGENT); }
                    dead = true; break; }
                __builtin_amdgcn_s_sleep(2);
            }
            __builtin_amdgcn_fence(__ATOMIC_ACQUIRE, "agent");
            if (lane == 0) flag[0] = dead ? 1u : 0u;
        }
        asm volatile("s_waitcnt vmcnt(0) lgkmcnt(0)" ::: "memory"); __builtin_amdgcn_s_barrier(); asm volatile("" ::: "memory");
        const bool bad = flag[0] != 0u;
        if (lane < 32) {
            const unsigned long long* slot = (const unsigned long long*)xbuf + (size_t)(u.pm * BM + row) * 4; float mt[4], m2[4]; float ms = 0.f;
#pragma unroll
            for (int t = 0; t < 4; ++t) { if (t < ntn) { const unsigned long long w = __hip_atomic_load(slot + t, __ATOMIC_RELAXED, __HIP_MEMORY_SCOPE_AGENT); mt[t] = __uint_as_float((unsigned)w); m2[t] = __uint_as_float((unsigned)(w >> 32)); } else { mt[t] = 0.f; m2[t] = 0.f; } ms += mt[t]; }
            const float mean = ms / (float)ntn; float q = 0.f;
#pragma unroll
            for (int t = 0; t < 4; ++t) if (t < ntn) { const float dm = mt[t] - mean; q += m2[t] + 256.0f * dm * dm; }
            S[row] = (f32x2v){mean, 1.0f / sqrtf(q / (256.0f * (float)ntn) + eps)};
        }
        asm volatile("s_waitcnt lgkmcnt(0)" ::: "memory"); __builtin_amdgcn_s_barrier(); asm volatile("" ::: "memory");
        return bad;
    }
};
struct EpiLnRes {
    static constexpr bool PERM = false, AFTER_DRAIN = true;
    const float* base; float* out; int ldc; const float* bias; PanelStats st; unsigned poison;
    __device__ __forceinline__ void fused(f32x4 (&acc)[2][2][4][2], const Unit& u, int wr, int wc, int fr, int fq, PG8_LAS unsigned char* lds, int wid, int lane) const {
        typedef float f32x2v __attribute__((ext_vector_type(2)));
        const PG8_LAS f32x2v* S = (const PG8_LAS f32x2v*)(lds + 8192);
        const int col0 = u.pn * BM + wc * 32 + 4 * fq;
#pragma unroll
        for (int bj = 0; bj < 2; ++bj)
#pragma unroll
            for (int n = 0; n < 2; ++n) { const f32x4 bv = bias ? *(const f32x4*)(bias + col0 + bj * HALF + n * 16) : (f32x4){0.f, 0.f, 0.f, 0.f};
#pragma unroll
                for (int ai = 0; ai < 2; ++ai)
#pragma unroll
                    for (int m = 0; m < 4; ++m) acc[ai][bj][m][n] += bv; }
        f32x4 pre[4][2][2];
#pragma unroll
        for (int m = 0; m < 4; ++m) { const size_t off = (size_t)(u.pm * BM + wr * 64 + m * 16 + fr) * ldc + col0;
#pragma unroll
            for (int bj = 0; bj < 2; ++bj)
#pragma unroll
                for (int n = 0; n < 2; ++n) pre[m][bj][n] = *(const f32x4*)(base + off + bj * HALF + n * 16); }
        const bool bad = st.run(acc, u, wr, wc, fr, fq, lds, wid, lane) || poison != 0u;
        const float qnan = __builtin_nanf("");
#pragma unroll
        for (int ai = 0; ai < 2; ++ai)
#pragma unroll
            for (int m = 0; m < 4; ++m) { const int r = ai * HALF + wr * 64 + m * 16 + fr; const f32x2v sr = S[r]; const size_t off = (size_t)(u.pm * BM + r) * ldc + col0;
#pragma unroll
                for (int bj = 0; bj < 2; ++bj)
#pragma unroll
                    for (int n = 0; n < 2; ++n) { const f32x4 bs = ai == 0 ? pre[m][bj][n] : *(const f32x4*)(base + off + bj * HALF + n * 16); f32x4 o = bs + (acc[ai][bj][m][n] - sr.x) * sr.y;
                        if (bad) o = (f32x4){qnan, qnan, qnan, qnan}; *(f32x4*)(out + off + bj * HALF + n * 16) = o; }
                if (m & 1) asm volatile("" ::: "memory"); }
    }
};
struct EpiLnResLn {
    static constexpr bool PERM = false, AFTER_DRAIN = true;
    const float* base; float* out; bf16_t* xn; int ldc; const float* bias; PanelStats st1, st2; unsigned poison;
    __device__ __forceinline__ void fused(f32x4 (&acc)[2][2][4][2], const Unit& u, int wr, int wc, int fr, int fq, PG8_LAS unsigned char* lds, int wid, int lane) const {
        typedef float f32x2v __attribute__((ext_vector_type(2))); typedef unsigned u32x2v __attribute__((ext_vector_type(2)));
        const PG8_LAS f32x2v* S = (const PG8_LAS f32x2v*)(lds + 8192);
        const int col0 = u.pn * BM + wc * 32 + 4 * fq;
#pragma unroll
        for (int bj = 0; bj < 2; ++bj)
#pragma unroll
            for (int n = 0; n < 2; ++n) { const f32x4 bv = bias ? *(const f32x4*)(bias + col0 + bj * HALF + n * 16) : (f32x4){0.f, 0.f, 0.f, 0.f};
#pragma unroll
                for (int ai = 0; ai < 2; ++ai)
#pragma unroll
                    for (int m = 0; m < 4; ++m) acc[ai][bj][m][n] += bv; }
        bool bad = st1.run(acc, u, wr, wc, fr, fq, lds, wid, lane) || poison != 0u;
        const float qnan = __builtin_nanf("");
#pragma unroll
        for (int ai = 0; ai < 2; ++ai)
#pragma unroll
            for (int m = 0; m < 4; ++m) { const int r = ai * HALF + wr * 64 + m * 16 + fr; const f32x2v sr = S[r]; const size_t off = (size_t)(u.pm * BM + r) * ldc + col0;
#pragma unroll
                for (int bj = 0; bj < 2; ++bj)
#pragma unroll
                    for (int n = 0; n < 2; ++n) { const f32x4 bs = *(const f32x4*)(base + off + bj * HALF + n * 16); acc[ai][bj][m][n] = bs + (acc[ai][bj][m][n] - sr.x) * sr.y; }
                asm volatile("" : "+v"(acc[ai][0][m][0]), "+v"(acc[ai][0][m][1]), "+v"(acc[ai][1][m][0]), "+v"(acc[ai][1][m][1]));
                if (m & 1) asm volatile("" ::: "memory"); }
        const bool bad1 = bad;
        bad = st2.run(acc, u, wr, wc, fr, fq, lds, wid, lane) || bad;
#pragma unroll
        for (int ai = 0; ai < 2; ++ai)
#pragma unroll
            for (int m = 0; m < 4; ++m) { const int r = ai * HALF + wr * 64 + m * 16 + fr; const f32x2v sr = S[r]; const size_t off = (size_t)(u.pm * BM + r) * ldc + col0;
#pragma unroll
                for (int bj = 0; bj < 2; ++bj)
#pragma unroll
                    for (int n = 0; n < 2; ++n) { const f32x4 x1 = acc[ai][bj][m][n]; *(f32x4*)(out + off + bj * HALF + n * 16) = bad1 ? (f32x4){qnan, qnan, qnan, qnan} : x1;
                        const f32x4 o = (x1 - sr.x) * sr.y; u32x2v w; w.x = cvt_pk_bf16(o[0], o[1]); w.y = cvt_pk_bf16(o[2], o[3]);
                        if (bad) { w.x = 0x7fc07fc0u; w.y = 0x7fc07fc0u; } *(u32x2v*)(xn + off + bj * HALF + n * 16) = w; }
                asm volatile("" ::: "memory"); }
    }
};

template <class Epi, class Sched, bool ALIGN_EPI = false, bool SP2 = false>
__device__ __forceinline__ void gemm_phase(PG8_LAS unsigned char* lds, const Gemm g, const Sched& S, const Epi& E) {
    const int tid = threadIdx.x, wid = __builtin_amdgcn_readfirstlane(tid >> 6), lane = tid & 63, wr = wid >> 2, wc = wid & 3, fr = lane & 15, fq = lane >> 4;
    const int K = g.K, nt = K / BK;
    unsigned voffA[2], voffB[2];
#pragma unroll
    for (int i = 0; i < 2; ++i) { int R, C; stage_rc(tid * 16 + i * 8192, R, C); const int Rb = Epi::PERM ? ((R & ~31) + perm32(R & 31)) : R;
        voffA[i] = (unsigned)(R * K + C) * 2u; voffB[i] = (unsigned)(Rb * K + C) * 2u; }
    const size_t kstep = (size_t)(BK * 2);
    const size_t hstep = (size_t)HALF * K * 2;
    const size_t tstep = 2 * hstep;
    const unsigned ldsw = (unsigned)wid * 1024u;
    const int aoff = lds_byte(wr * 64 + fr, fq * 8), boff = lds_byte(wc * 32 + fr, fq * 8);
#define PG8_SA(b, h) (((b) * 2 + (h)) * HTB)
#define PG8_SB(b, h) ((4 + (b) * 2 + (h)) * HTB)
#define PG8_STAGE(bufoff, gbase, voff) do { _Pragma("unroll") for (int _i = 0; _i < 2; ++_i) \
        __builtin_amdgcn_global_load_lds((const unsigned*)((const char*)(gbase) + (voff)[_i]), (PG8_LAS unsigned*)(lds + (bufoff) + ldsw + _i * 8192), 16, 0, 0); } while (0)
#define PG8_LDA(dst, b, h) do { _Pragma("unroll") for (int m = 0; m < 4; ++m) _Pragma("unroll") for (int k = 0; k < 2; ++k) dst[m][k] = *(const PG8_LAS bf16x8*)(lds + PG8_SA(b, h) + aoff + m * 2048 + k * 1024); } while (0)
#define PG8_LDB(dst, b, h) do { _Pragma("unroll") for (int n = 0; n < 2; ++n) _Pragma("unroll") for (int k = 0; k < 2; ++k) dst[n][k] = *(const PG8_LAS bf16x8*)(lds + PG8_SB(b, h) + boff + n * 2048 + k * 1024); } while (0)
#define PG8_MMA(ai, bj, At, Bt) do { __builtin_amdgcn_s_setprio(1); _Pragma("unroll") for (int m = 0; m < 4; ++m) _Pragma("unroll") for (int n = 0; n < 2; ++n) _Pragma("unroll") for (int k = 0; k < 2; ++k) \
        acc[ai][bj][m][n] = __builtin_amdgcn_mfma_f32_16x16x32_bf16(Bt[n][k], At[m][k], acc[ai][bj][m][n], 0, 0, 0); __builtin_amdgcn_s_setprio(0); } while (0)
#define PG8_WAIT_V(n) asm volatile("s_waitcnt vmcnt(" #n ")" ::: "memory")
#define PG8_WAIT_L(n) asm volatile("s_waitcnt lgkmcnt(" #n ")" ::: "memory")
#define PG8_BAR __builtin_amdgcn_s_barrier()
#define PG8_SCHED __builtin_amdgcn_sched_barrier(0)
    Unit cur, nxt; int ui = 0;
    if (!S.next(0, cur)) return;
    f32x4 acc[2][2][4][2];
#pragma unroll
    for (int a = 0; a < 2; ++a)
#pragma unroll
        for (int b = 0; b < 2; ++b)
#pragma unroll
            for (int m = 0; m < 4; ++m)
#pragma unroll
                for (int n = 0; n < 2; ++n) acc[a][b][m][n] = (f32x4){0.f, 0.f, 0.f, 0.f};
    bf16x8 At[4][2], B0[2][2], B1[2][2];
    const char* cA = (const char*)g.A + (size_t)cur.pm * tstep; const char* cB = (const char*)g.Bt + (size_t)cur.pn * tstep;
    S.a_ready(cur);
    if constexpr (SP2) {
        PG8_STAGE(PG8_SB(0, 0), cB, voffB); PG8_STAGE(PG8_SB(0, 1), cB + hstep, voffB); PG8_STAGE(PG8_SA(0, 0), cA, voffA); PG8_STAGE(PG8_SA(0, 1), cA + hstep, voffA);
        if (wr == 1) PG8_BAR;
        PG8_WAIT_V(2); PG8_BAR;
        PG8_STAGE(PG8_SB(1, 0), cB + kstep, voffB); PG8_STAGE(PG8_SA(1, 0), cA + kstep, voffA); PG8_STAGE(PG8_SB(1, 1), cB + hstep + kstep, voffB);
        PG8_WAIT_V(6); PG8_BAR;
    } else {
        PG8_STAGE(PG8_SB(0, 0), cB, voffB); PG8_STAGE(PG8_SA(0, 0), cA, voffA); PG8_STAGE(PG8_SB(0, 1), cB + hstep, voffB); PG8_STAGE(PG8_SA(0, 1), cA + hstep, voffA);
        if (wr == 1) PG8_BAR;
        PG8_WAIT_V(4); PG8_BAR;
        PG8_STAGE(PG8_SB(1, 0), cB + kstep, voffB); PG8_STAGE(PG8_SA(1, 0), cA + kstep, voffA); PG8_STAGE(PG8_SB(1, 1), cB + hstep + kstep, voffB);
        PG8_WAIT_V(6); PG8_BAR;
    }
    for (;;) {
        const bool has_next = S.next(ui + 1, nxt);
        const char* nA = has_next ? (const char*)g.A + (size_t)nxt.pm * tstep : cA; const char* nB = has_next ? (const char*)g.Bt + (size_t)nxt.pn * tstep : cB;
        for (int t = 0; t < nt; t += 2) {
            const bool last = (t == nt - 2);
            const char* a1 = cA + (size_t)(t + 1) * kstep;
            const char* a2 = last ? nA : cA + (size_t)(t + 2) * kstep; const char* b2 = last ? nB : cB + (size_t)(t + 2) * kstep;
            const char* a3 = a2 + kstep; const char* b3 = b2 + kstep;
            if (last && has_next) S.a_ready(nxt);
            if constexpr (SP2) {
            PG8_LDB(B0, 0, 0); PG8_LDB(B1, 0, 1); PG8_SCHED; PG8_LDA(At, 0, 0); PG8_STAGE(PG8_SA(1, 1), a1 + hstep, voffA);
            PG8_WAIT_V(8); PG8_WAIT_L(0); PG8_BAR; PG8_MMA(0, 0, At, B0); PG8_MMA(0, 1, At, B1); PG8_BAR; PG8_SCHED;
            PG8_LDA(At, 0, 1); PG8_STAGE(PG8_SB(0, 0), b2, voffB); PG8_STAGE(PG8_SB(0, 1), b2 + hstep, voffB); PG8_STAGE(PG8_SA(0, 0), a2, voffA);
            PG8_WAIT_V(8); PG8_WAIT_L(0); PG8_BAR; PG8_MMA(1, 0, At, B0); PG8_MMA(1, 1, At, B1); PG8_BAR; PG8_SCHED;
            PG8_LDB(B0, 1, 0); PG8_LDB(B1, 1, 1); PG8_SCHED; PG8_LDA(At, 1, 0); PG8_STAGE(PG8_SA(0, 1), a2 + hstep, voffA);
            PG8_WAIT_V(8); PG8_WAIT_L(0); PG8_BAR; PG8_MMA(0, 0, At, B0); PG8_MMA(0, 1, At, B1); PG8_BAR; PG8_SCHED;
            PG8_LDA(At, 1, 1); PG8_STAGE(PG8_SB(1, 0), b3, voffB); PG8_STAGE(PG8_SB(1, 1), b3 + hstep, voffB); PG8_STAGE(PG8_SA(1, 0), a3, voffA);
            PG8_WAIT_V(8); PG8_WAIT_L(0); PG8_BAR; PG8_MMA(1, 0, At, B0); PG8_MMA(1, 1, At, B1); PG8_BAR; PG8_SCHED;
            } else {
            PG8_LDB(B0, 0, 0); PG8_SCHED; PG8_LDA(At, 0, 0); PG8_STAGE(PG8_SA(1, 1), a1 + hstep, voffA);
            PG8_WAIT_L(8); PG8_BAR; PG8_WAIT_L(0); PG8_MMA(0, 0, At, B0); PG8_BAR; PG8_SCHED;
            PG8_LDB(B1, 0, 1); PG8_STAGE(PG8_SB(0, 0), b2, voffB);
            PG8_BAR; PG8_WAIT_L(0); PG8_MMA(0, 1, At, B1); PG8_BAR;
            PG8_LDA(At, 0, 1); PG8_STAGE(PG8_SA(0, 0), a2, voffA);
            PG8_BAR; PG8_WAIT_L(0); PG8_MMA(1, 0, At, B0); PG8_BAR; PG8_SCHED;
            PG8_STAGE(PG8_SB(0, 1), b2 + hstep, voffB);
            PG8_WAIT_V(6); PG8_BAR; PG8_MMA(1, 1, At, B1); PG8_BAR;
            PG8_LDB(B0, 1, 0); PG8_SCHED; PG8_LDA(At, 1, 0); PG8_STAGE(PG8_SA(0, 1), a2 + hstep, voffA);
            PG8_WAIT_L(8); PG8_BAR; PG8_WAIT_L(0); PG8_MMA(0, 0, At, B0); PG8_BAR; PG8_SCHED;
            PG8_LDB(B1, 1, 1); PG8_STAGE(PG8_SB(1, 0), b3, voffB);
            PG8_BAR; PG8_WAIT_L(0); PG8_MMA(0, 1, At, B1); PG8_BAR;
            PG8_LDA(At, 1, 1); PG8_STAGE(PG8_SA(1, 0), a3, voffA);
            PG8_BAR; PG8_WAIT_L(0); PG8_MMA(1, 0, At, B0); PG8_BAR; PG8_SCHED;
            PG8_STAGE(PG8_SB(1, 1), b3 + hstep, voffB);
            PG8_WAIT_V(6); PG8_BAR; PG8_MMA(1, 1, At, B1); PG8_BAR;
            }
        }
        if constexpr (ALIGN_EPI) { if (wr == 0) PG8_BAR; }
        if constexpr (!Epi::AFTER_DRAIN) { E(acc, cur, wr, wc, fr, fq); S.done(cur); }
        if (!has_next) break;
#pragma unroll
        for (int a = 0; a < 2; ++a)
#pragma unroll
            for (int b = 0; b < 2; ++b)
#pragma unroll
                for (int m = 0; m < 4; ++m)
#pragma unroll
                    for (int n = 0; n < 2; ++n) acc[a][b][m][n] = (f32x4){0.f, 0.f, 0.f, 0.f};
        cur = nxt; cA = nA; cB = nB; ++ui;
        if constexpr (ALIGN_EPI) { if (wr == 1) PG8_BAR; }
    }
    PG8_WAIT_V(0);
    if constexpr (!ALIGN_EPI) { if (wr == 0) PG8_BAR; }
    PG8_BAR;
    if constexpr (Epi::AFTER_DRAIN) { E.fused(acc, cur, wr, wc, fr, fq, lds, wid, lane); S.done(cur); }
#undef PG8_SA
#undef PG8_SB
#undef PG8_STAGE
#undef PG8_LDA
#undef PG8_LDB
#undef PG8_MMA
#undef PG8_WAIT_V
#undef PG8_WAIT_L
#undef PG8_BAR
#undef PG8_SCHED
}
}

#ifndef PG8_SP2
#define PG8_SP2 true
#endif
#ifndef PG8_ALIGN
#define PG8_ALIGN true
#endif
#include <hip/hip_bf16.h>
#include <hip/hip_bf16.h>
#include <cmath>
#ifndef ATT_ORIG
#define ATT_ORIG 0
#endif
namespace attn_body {
using bf16=__hip_bfloat16;
using bf16x8=__attribute__((ext_vector_type(8)))short;
using s16x4=__attribute__((ext_vector_type(4)))short;
using f32x16=__attribute__((ext_vector_type(16)))float;
using u32x4=__attribute__((ext_vector_type(4)))unsigned;
constexpr int BATCH=4,NHEAD=16,SEQ=2048,D=64,DM=NHEAD*D;
constexpr int NW=8,QBLK=32,QB=QBLK*NW,KVBLK=64,NQB=SEQ/QB;
constexpr int ATTN_PITCH=DM, ATTN_UNIT_ROWS=QB;
__device__ __forceinline__ int crow(int r,int hi){return (r&3)+8*(r>>2)+4*hi;}
#define SBAR() __builtin_amdgcn_sched_barrier(0)
__device__ __forceinline__ void cmask(f32x16&p0,f32x16&p1,int jb,int qrel,int hi){
  const float NEG=-INFINITY; int kb=64*jb+4*hi;
  #pragma unroll
  for(int r=0;r<16;++r){int kv=kb+(r&3)+8*(r>>2); if(kv>qrel)p0[r]=NEG; if(kv+32>qrel)p1[r]=NEG;}
}

constexpr int NSLOT=3, SLOTB=8192;
constexpr int LDS_K=0, LDS_V=NSLOT*SLOTB, LDS_WS=2*NSLOT*SLOTB, LDS_OST=LDS_WS+NW*64*4, LDS_TBX=LDS_OST+NW*4096, LDS_BYTES=LDS_TBX+640*4;
constexpr float C2=0.125f*1.4426950408889634f;
__device__ __forceinline__ void glds16(const void*gsrc,unsigned lds_dst){unsigned keep;
  asm volatile("s_mov_b32 %0, m0\n\ts_mov_b32 m0, %2\n\ts_nop 0\n\tglobal_load_lds_dwordx4 %1, off\n\ts_mov_b32 m0, %0":"=&s"(keep):"v"(gsrc),"s"(lds_dst):"memory");}
__device__ __forceinline__ float max3f(float a,float b,float c){float r;asm("v_max3_f32 %0, %1, %2, %3":"=v"(r):"v"(a),"v"(b),"v"(c));return r;}
__device__ __forceinline__ float max2f(float a,float b){float r;asm("v_max_f32_e32 %0, %1, %2":"=v"(r):"v"(a),"v"(b));return r;}
__device__ __forceinline__ float fadd_s(float a,float b){float r;asm("v_add_f32_e32 %0, %1, %2":"=v"(r):"v"(a),"v"(b));return r;}
__device__ __forceinline__ float fsub_s(float a,float b){float r;asm("v_sub_f32_e32 %0, %1, %2":"=v"(r):"v"(a),"v"(b));return r;}
typedef float f32x2_t __attribute__((ext_vector_type(2))); typedef __bf16 bf16x2_t __attribute__((ext_vector_type(2)));
__device__ __forceinline__ unsigned cvtpk_s(float lo,float hi){f32x2_t v={lo,hi};bf16x2_t b=__builtin_convertvector(v,bf16x2_t);return __builtin_bit_cast(unsigned,b);}
#define WAIT_BAR(N) asm volatile("s_waitcnt vmcnt(" #N ") lgkmcnt(0)\n\ts_barrier":::"memory")

__device__ __forceinline__ void qkt(f32x16&p0,f32x16&p1,const char*Kslot,const bf16x8*qr,const f32x16&negm,int r32,int hi){
  const char*kb=Kslot+hi*1024+r32*16;
  #pragma unroll
  for(int d0=0;d0<4;++d0){
    const bf16x8 b0=*reinterpret_cast<const bf16x8*>(kb+d0*2048);
    const bf16x8 b1=*reinterpret_cast<const bf16x8*>(kb+d0*2048+512);
    if(d0==0){p0=__builtin_amdgcn_mfma_f32_32x32x16_bf16(b0,qr[0],negm,0,0,0);p1=__builtin_amdgcn_mfma_f32_32x32x16_bf16(b1,qr[0],negm,0,0,0);}
    else{p0=__builtin_amdgcn_mfma_f32_32x32x16_bf16(b0,qr[d0],p0,0,0,0);p1=__builtin_amdgcn_mfma_f32_32x32x16_bf16(b1,qr[d0],p1,0,0,0);}}
}
typedef __attribute__((address_space(3))) const char* lds_cptr;
typedef short v4i16_t __attribute__((ext_vector_type(4)));
__device__ __forceinline__ void kload8(bf16x8*kf,lds_cptr kp){
  kf[0]=*(const __attribute__((address_space(3))) bf16x8*)(kp);      kf[1]=*(const __attribute__((address_space(3))) bf16x8*)(kp+512);
  kf[2]=*(const __attribute__((address_space(3))) bf16x8*)(kp+2048); kf[3]=*(const __attribute__((address_space(3))) bf16x8*)(kp+2560);
  kf[4]=*(const __attribute__((address_space(3))) bf16x8*)(kp+4096); kf[5]=*(const __attribute__((address_space(3))) bf16x8*)(kp+4608);
  kf[6]=*(const __attribute__((address_space(3))) bf16x8*)(kp+6144); kf[7]=*(const __attribute__((address_space(3))) bf16x8*)(kp+6656);
}
__device__ __forceinline__ void kload2(bf16x8*kf,lds_cptr kp,int j){ kf[2*j]=*(const __attribute__((address_space(3))) bf16x8*)(kp+j*2048); kf[2*j+1]=*(const __attribute__((address_space(3))) bf16x8*)(kp+j*2048+512); }
__device__ __forceinline__ s16x4 vtr(lds_cptr p){ return __builtin_bit_cast(s16x4,__builtin_amdgcn_ds_read_tr16_b64_v4i16((__attribute__((address_space(3))) v4i16_t*)p)); }
__device__ __forceinline__ float rowmax(const f32x16&p0,const f32x16&p1){
  float a=max3f(p0[0],p0[1],p1[0]),b=max3f(p0[2],p0[3],p1[1]);a=max3f(a,p1[2],p1[3]);
  #pragma unroll
  for(int r=4;r<16;r+=4){a=max3f(a,p0[r],p0[r+1]);b=max3f(b,p0[r+2],p0[r+3]);a=max3f(a,p1[r],p1[r+1]);b=max3f(b,p1[r+2],p1[r+3]);}
  const float m=max2f(a,b);
  auto rr=__builtin_amdgcn_permlane32_swap(__float_as_uint(m),__float_as_uint(m),false,false);
  return max2f(__uint_as_float(rr[0]),__uint_as_float(rr[1]));
}
__device__ __forceinline__ void pv(f32x16*o,int vb,bf16x8 pa0,bf16x8 pa1,bf16x8 pa2,bf16x8 pa3){
  #pragma unroll
  for(int d0=0;d0<2;++d0){s16x4 lo[4],hi[4];
    #pragma unroll
    for(int ks=0;ks<4;++ks){
      asm volatile("ds_read_b64_tr_b16 %0,%1 offset:%c2":"=&v"(lo[ks]):"v"(vb),"i"(d0*4096+ks*1024):"memory");
      asm volatile("ds_read_b64_tr_b16 %0,%1 offset:%c2":"=&v"(hi[ks]):"v"(vb),"i"(d0*4096+ks*1024+512):"memory");}
    asm volatile("s_waitcnt lgkmcnt(0)":::"memory");SBAR();
    #define PK(k) (bf16x8){lo[k][0],lo[k][1],lo[k][2],lo[k][3],hi[k][0],hi[k][1],hi[k][2],hi[k][3]}
    o[d0]=__builtin_amdgcn_mfma_f32_32x32x16_bf16(pa0,PK(0),o[d0],0,0,0);
    o[d0]=__builtin_amdgcn_mfma_f32_32x32x16_bf16(pa1,PK(1),o[d0],0,0,0);
    o[d0]=__builtin_amdgcn_mfma_f32_32x32x16_bf16(pa2,PK(2),o[d0],0,0,0);
    o[d0]=__builtin_amdgcn_mfma_f32_32x32x16_bf16(pa3,PK(3),o[d0],0,0,0);
    #undef PK
  }
}

#ifndef ATTN_STORE16
#define ATTN_STORE16(p,v) (*(u32x4*)(p)=(v))
#endif
template<int THRL> __device__ __forceinline__ void attn_unit(int b,int koff,int voff,int qb,const bf16*Q,const bf16*__restrict__ K,const bf16*__restrict__ V,bf16*O,char*shm){
  const int tid=threadIdx.x,lane=tid&63,r32=lane&31,hi=lane>>5; const int wid=__builtin_amdgcn_readfirstlane(tid>>6);
  const long rowbase=(long)b*SEQ; const int q0=qb*QB;
  const bf16*Qw=Q+(rowbase+q0+wid*QBLK)*DM+koff;
  const bf16*Kh=K+rowbase*DM+koff,*Vh=V+rowbase*DM+voff;
  const unsigned lds0=(unsigned)(uintptr_t)shm;
  float*wsf=(float*)(shm+LDS_WS)+wid*64;
  const bf16*ksrc=Kh+(long)lane*DM+wid*8;
  const bf16*vsrc=Vh+(long)(16*(wid&3)+(lane>>2))*DM+(wid>>2)*32+(lane&3)*8;
  const unsigned kdst=lds0+LDS_K+wid*1024, vdst=lds0+LDS_V+wid*1024;
  #define DMA_K(t,slot) glds16(ksrc+(long)(t)*KVBLK*DM,(unsigned)__builtin_amdgcn_readfirstlane(kdst+(slot)))
  #define DMA_V(t,slot) glds16(vsrc+(long)(t)*KVBLK*DM,(unsigned)__builtin_amdgcn_readfirstlane(vdst+(slot)))
  const int vb0=(int)(lds0+LDS_V)+((lane>>4)&1)*32+(lane&3)*8+(4*hi+((lane&15)>>2))*64;
  const char*Kbase=shm+LDS_K; bf16x8 kf[8];
  const lds_cptr shm3=(lds_cptr)shm; const lds_cptr kp0=shm3+LDS_K+hi*1024+r32*16; const lds_cptr vp0=shm3+LDS_V+((lane>>4)&1)*32+(lane&3)*8+(4*hi+((lane&15)>>2))*64;
  const int NT=(q0+QB)/KVBLK;
  typedef __attribute__((address_space(3))) float ldsf_t;
  DMA_K(0,0);DMA_V(0,0);DMA_K(1,SLOTB);
  bf16x8 qr[4];
  #pragma unroll
  for(int d0=0;d0<4;++d0)qr[d0]=*reinterpret_cast<const bf16x8*>(&Qw[(long)r32*DM+d0*16+hi*8]);
  float mhat=0.f,l_reg=0.f;f32x16 o[2];o[0]=f32x16{};o[1]=f32x16{};f32x16 negm=f32x16{};asm volatile("":"+v"(negm));
  const int qrel=wid*QBLK+r32;
  #define CMASK(P0,P1,t) do{int jb_=(t)-(NT-4); if(jb_>=0)cmask(P0,P1,jb_,qrel,hi);}while(0)
  #define TBP_(jb) ((const ldsf_t*)(shm3+LDS_TBX)+(256+qx_-64*(jb)))
  #define CBIAS_ON(P0,P1,t) do{int jb_=(t)-(NT-4); if(jb_>=-2){ int qx_=qrel-4*hi; asm volatile("":"+v"(qx_)); const ldsf_t*tp_=TBP_(jb_); \
      _Pragma("unroll") for(int r0_=0;r0_<16;r0_+=8){ _Pragma("unroll") for(int r=r0_;r<r0_+8;++r){const int kr_=(r&3)+8*(r>>2); P0[r]+=tp_[-kr_];} SBAR(); } \
      _Pragma("unroll") for(int r0_=0;r0_<16;r0_+=8){ _Pragma("unroll") for(int r=r0_;r<r0_+8;++r){const int kr_=(r&3)+8*(r>>2); P1[r]+=tp_[-kr_-32];} SBAR(); } } }while(0)
  #define CBSUB(P0,P1,t) do{int jb_=(t)-(NT-4); if(jb_>=-2){ int qx_=qrel-4*hi; asm volatile("":"+v"(qx_)); const ldsf_t*tp_=TBP_(jb_); \
      _Pragma("unroll") for(int r0_=0;r0_<16;r0_+=8){ _Pragma("unroll") for(int r=r0_;r<r0_+8;++r){const int kr_=(r&3)+8*(r>>2); P0[r]+=(tp_[-kr_]-mhat);} SBAR(); } \
      _Pragma("unroll") for(int r0_=0;r0_<16;r0_+=8){ _Pragma("unroll") for(int r=r0_;r<r0_+8;++r){const int kr_=(r&3)+8*(r>>2); P1[r]+=(tp_[-kr_-32]-mhat);} SBAR(); } } \
    else { _Pragma("unroll") for(int r=0;r<16;++r){P0[r]-=mhat;P1[r]-=mhat;} } }while(0)
  #define CINIT(B) ((B)?(f32x16){0.f,0.f,0.f,0.f,0.f,0.f,0.f,0.f,0.f,0.f,0.f,0.f,0.f,0.f,0.f,0.f}:negm)
  #define CBIAS(P0,P1,t) do{ if(!(ATT_ORIG&1)){CBIAS_ON(P0,P1,t);} }while(0)
  bool resc=false;
  #define START(P0,P1) do{ const float rm=rowmax(P0,P1); resc=false; \
    { const float dl=rm; mhat=fadd_s(mhat,dl); \
      _Pragma("unroll") for(int r=0;r<16;++r){P0[r]=fsub_s(P0[r],dl);P1[r]=fsub_s(P1[r],dl);} \
      _Pragma("unroll") for(int r=0;r<16;++r)negm[r]=-mhat; asm volatile("":"+v"(negm)); } \
    _Pragma("unroll") for(int r=0;r<16;++r)P0[r]=__builtin_amdgcn_exp2f(P0[r]); }while(0)
  #define RESC() do{ if(resc){ asm volatile("s_waitcnt lgkmcnt(0)":::"memory"); \
      _Pragma("unroll") for(int d_=0;d_<2;++d_) _Pragma("unroll") for(int r=0;r<16;++r)o[d_][r]*=wsf[crow(r,hi)]; } }while(0)
  f32x16 pA0,pA1,pB0,pB1;
  int sl_prev=0,sl_cur=0,sl_next=SLOTB;
  #define ROT() do{sl_prev=sl_cur;sl_cur=sl_next;sl_next=(sl_next==(NSLOT-1)*SLOTB)?0:sl_next+SLOTB;}while(0)
  DMA_K(2,2*SLOTB);
  WAIT_BAR(3);
  qkt(pA0,pA1,Kbase,qr,negm,r32,hi);asm volatile("s_nop 15\n\ts_nop 7":"+v"(pA0),"+v"(pA1));CBIAS(pA0,pA1,0);CMASK(pA0,pA1,0);
  START(pA0,pA1);
  _Pragma("unroll") for(int r=0;r<16;++r)pA1[r]=__builtin_amdgcn_exp2f(pA1[r]);
  WAIT_BAR(0);
  DMA_K(3,0);DMA_V(1,SLOTB);
  ROT();
  kload8(kf,kp0+sl_cur);
  WAIT_BAR(2);
  s16x4 vlo[8],vhi[8]; u32x4 pw0,pw1,pw2,pw3;
  #define PKW(P,B) cvtpk_s(P[B],P[B+1])
  #define PAF(k) __builtin_bit_cast(bf16x8,pw##k)
  #define VFR(i) (bf16x8){vlo[i][0],vlo[i][1],vlo[i][2],vlo[i][3],vhi[i][0],vhi[i][1],vhi[i][2],vhi[i][3]}
  #define PIN(x) asm volatile("":"+v"(x))
  #define MX3(a,b,c) __builtin_fmaxf(__builtin_fmaxf((a),(b)),(c))
  #define GAPA(MF,A0,A1,A2,A3,W0,W1,PW) do{ MF; sacc+=A0; sacc+=A1; sacc+=A2; sacc+=A3; PIN(sacc); W0; W1; PIN(PW); SBAR(); }while(0)
  #define EX(v) __builtin_amdgcn_exp2f(v)
  #define GAPB(MF,X,B) do{ MF; X[B]=EX(X[B]); X[B+1]=EX(X[B+1]); X[B+2]=EX(X[B+2]); X[B+3]=EX(X[B+3]); PIN(X); SBAR(); }while(0)
  #define VRD(i) do{ vlo[i]=vtr(vp_+(((i)>>2)*4096+((i)&3)*1024)); vhi[i]=vtr(vp_+(((i)>>2)*4096+((i)&3)*1024+512)); }while(0)
  #define KRD(G,j) do{ if(G){ kload2(kf,kp0+sl_next,j); SBAR(); } }while(0)
  #define STEP(C0,C1,P0,P1,t,GK,GV,GL,BAND_) do{ constexpr int BAND=((ATT_ORIG&1)?0:(BAND_)); constexpr int ZC=(ATT_ORIG&4)?0:BAND; SBAR(); \
    const lds_cptr vp_=vp0+sl_prev; \
    VRD(0); SBAR(); float sacc=(P0[0]+P0[1]); \
    GAPA(C0=__builtin_amdgcn_mfma_f32_32x32x16_bf16(kf[0],qr[0],CINIT(ZC),0,0,0), P0[2],P0[3],P0[4],P0[5],     pw0[0]=PKW(P0,0), pw0[1]=PKW(P0,2), pw0); \
    VRD(4); SBAR(); GAPA(C1=__builtin_amdgcn_mfma_f32_32x32x16_bf16(kf[1],qr[0],CINIT(ZC),0,0,0), P0[6],P0[7],P0[8],P0[9],     pw0[2]=PKW(P0,4), pw0[3]=PKW(P0,6), pw0); \
    VRD(1); SBAR(); GAPA(C0=__builtin_amdgcn_mfma_f32_32x32x16_bf16(kf[2],qr[1],C0,0,0,0),   P0[10],P0[11],P0[12],P0[13], pw1[0]=PKW(P0,8), pw1[1]=PKW(P0,10), pw1); \
    VRD(5); SBAR(); GAPA(C1=__builtin_amdgcn_mfma_f32_32x32x16_bf16(kf[3],qr[1],C1,0,0,0),   P0[14],P0[15],P1[0],P1[1],   pw1[2]=PKW(P0,12),pw1[3]=PKW(P0,14), pw1); \
    VRD(2); SBAR(); GAPA(C0=__builtin_amdgcn_mfma_f32_32x32x16_bf16(kf[4],qr[2],C0,0,0,0),   P1[2],P1[3],P1[4],P1[5],     pw2[0]=PKW(P1,0), pw2[1]=PKW(P1,2), pw2); \
    VRD(6); SBAR(); GAPA(C1=__builtin_amdgcn_mfma_f32_32x32x16_bf16(kf[5],qr[2],C1,0,0,0),   P1[6],P1[7],P1[8],P1[9],     pw2[2]=PKW(P1,4), pw2[3]=PKW(P1,6), pw2); \
    VRD(3); SBAR(); GAPA(C0=__builtin_amdgcn_mfma_f32_32x32x16_bf16(kf[6],qr[3],C0,0,0,0),   P1[10],P1[11],P1[12],P1[13], pw3[0]=PKW(P1,8), pw3[1]=PKW(P1,10), pw3); \
    VRD(7); SBAR(); GAPA(C1=__builtin_amdgcn_mfma_f32_32x32x16_bf16(kf[7],qr[3],C1,0,0,0),   P1[14],P1[15],0.f,0.f,       pw3[2]=PKW(P1,12),pw3[3]=PKW(P1,14), pw3); \
    l_reg+=sacc; \
    if(GK){DMA_K((t)+3,sl_cur);} if(GV){DMA_V((t)+1,sl_next);} \
    if(ZC){ CBSUB(C0,C1,t); } else if(BAND){ CBIAS_ON(C0,C1,t); } CMASK(C0,C1,t); \
    { float a=MX3(C0[0],C0[1],C1[0]),b=MX3(C0[2],C0[3],C1[1]); a=MX3(a,C1[2],C1[3]); \
      _Pragma("unroll") for(int r=4;r<16;r+=4){a=MX3(a,C0[r],C0[r+1]);b=MX3(b,C0[r+2],C0[r+3]);a=MX3(a,C1[r],C1[r+1]);b=MX3(b,C1[r+2],C1[r+3]);} \
      float rm=__builtin_fmaxf(a,b); { auto rr=__builtin_amdgcn_permlane32_swap(__float_as_uint(rm),__float_as_uint(rm),false,false); rm=__builtin_fmaxf(__uint_as_float(rr[0]),__uint_as_float(rr[1])); } \
      resc=false; \
      if(__builtin_expect(__any(rm>(float)THRL),0)){ const float dl=__builtin_fmaxf(rm,0.f); mhat+=dl; \
        _Pragma("unroll") for(int r=0;r<16;++r){C0[r]-=dl;C1[r]-=dl;} \
        if(!(ZC)){ _Pragma("unroll") for(int r=0;r<16;++r)negm[r]=-mhat; asm volatile("":"+v"(negm)); } \
        const float f=__builtin_amdgcn_exp2f(-dl); l_reg*=f; if(hi==0)wsf[r32]=f; resc=true; } } \
    SBAR(); \
    GAPB(o[0]=__builtin_amdgcn_mfma_f32_32x32x16_bf16(PAF(0),VFR(0),o[0],0,0,0), C0,0); \
    GAPB(o[1]=__builtin_amdgcn_mfma_f32_32x32x16_bf16(PAF(0),VFR(4),o[1],0,0,0), C0,4); \
    KRD(GL,0); GAPB(o[0]=__builtin_amdgcn_mfma_f32_32x32x16_bf16(PAF(1),VFR(1),o[0],0,0,0), C0,8); \
    KRD(GL,1); GAPB(o[1]=__builtin_amdgcn_mfma_f32_32x32x16_bf16(PAF(1),VFR(5),o[1],0,0,0), C0,12); \
    KRD(GL,2); GAPB(o[0]=__builtin_amdgcn_mfma_f32_32x32x16_bf16(PAF(2),VFR(2),o[0],0,0,0), C1,0); \
    KRD(GL,3); GAPB(o[1]=__builtin_amdgcn_mfma_f32_32x32x16_bf16(PAF(2),VFR(6),o[1],0,0,0), C1,4); \
    GAPB(o[0]=__builtin_amdgcn_mfma_f32_32x32x16_bf16(PAF(3),VFR(3),o[0],0,0,0), C1,8); \
    GAPB(o[1]=__builtin_amdgcn_mfma_f32_32x32x16_bf16(PAF(3),VFR(7),o[1],0,0,0), C1,12); \
    }while(0)
  int t=1;
  #undef CMASK
  #define CMASK(P0,P1,t) do{}while(0)
  #undef CBIAS
  #define CBIAS(P0,P1,t) do{}while(0)
  for(;t+((ATT_ORIG&2)?5:7)<NT;t+=2){
    STEP(pB0,pB1,pA0,pA1,t,true,true,true,0);     WAIT_BAR(2); RESC(); ROT();
    STEP(pA0,pA1,pB0,pB1,t+1,true,true,true,0);   WAIT_BAR(2); RESC(); ROT();
  }
  #undef CMASK
  #define CMASK(P0,P1,t) do{int jb_=(t)-(NT-4); if(jb_>=0)cmask(P0,P1,jb_,qrel,hi);}while(0)
  #undef CBIAS
  #define CBIAS(P0,P1,t) do{ if(!(ATT_ORIG&1)){CBIAS_ON(P0,P1,t);} }while(0)
  #define ENDW(tt) do{ if((tt)+3<NT){WAIT_BAR(2);} else if((tt)+2<NT){WAIT_BAR(1);} else {WAIT_BAR(0);} }while(0)
  for(;t+1<NT;t+=2){
    STEP(pB0,pB1,pA0,pA1,t,(t+3<NT),(t+1<NT),(t+1<NT),1);       ENDW(t);   RESC(); ROT();
    STEP(pA0,pA1,pB0,pB1,t+1,(t+4<NT),(t+2<NT),(t+2<NT),1);     ENDW(t+1); RESC(); ROT();
  }
  STEP(pB0,pB1,pA0,pA1,NT-1,false,false,false,1); RESC();
  { float sacc=pB0[0]+pB0[1]; _Pragma("unroll") for(int r=2;r<16;++r)sacc+=pB0[r]; _Pragma("unroll") for(int r=0;r<16;++r)sacc+=pB1[r]; l_reg+=sacc;
    pw0=(u32x4){PKW(pB0,0),PKW(pB0,2),PKW(pB0,4),PKW(pB0,6)};pw1=(u32x4){PKW(pB0,8),PKW(pB0,10),PKW(pB0,12),PKW(pB0,14)};pw2=(u32x4){PKW(pB1,0),PKW(pB1,2),PKW(pB1,4),PKW(pB1,6)};pw3=(u32x4){PKW(pB1,8),PKW(pB1,10),PKW(pB1,12),PKW(pB1,14)};
    SBAR(); pv(o,vb0+sl_cur,PAF(0),PAF(1),PAF(2),PAF(3)); }
  #undef PKW
  #undef PAF
  #undef VFR
  #undef PIN
  #undef MX3
  #undef GAPA
  #undef GAPB
  #undef EX
  #undef VRD
  #undef KRD
  #undef STEP
  #undef ENDW
  {auto rr=__builtin_amdgcn_permlane32_swap(__float_as_uint(l_reg),__float_as_uint(l_reg),false,false);l_reg=__uint_as_float(rr[0])+__uint_as_float(rr[1]);}
  if(hi==0)wsf[32+r32]=l_reg;asm volatile("s_waitcnt lgkmcnt(0)":::"memory");
  float rli[16];
  #pragma unroll
  for(int r=0;r<16;++r)rli[r]=__builtin_amdgcn_rcpf(wsf[32+crow(r,hi)]);
  bf16*Ow=O+(rowbase+q0+wid*QBLK)*DM+voff;
  { bf16*stg=(bf16*)(shm+LDS_OST)+wid*2048;
    #pragma unroll
    for(int r=0;r<16;++r){const int orow=crow(r,hi);
      #pragma unroll
      for(int d0=0;d0<2;++d0)stg[orow*64+d0*32+r32]=__float2bfloat16(o[d0][r]*rli[r]);}
    asm volatile("s_waitcnt lgkmcnt(0)":::"memory");
    #pragma unroll
    for(int i=0;i<4;++i){const int row=i*8+(lane>>3),ch=lane&7; const u32x4 v=*(const u32x4*)(stg+row*64+ch*8); ATTN_STORE16(Ow+(long)row*DM+ch*8,v);} }
  asm volatile("s_waitcnt lgkmcnt(0)\n\ts_barrier":::"memory");
  #undef DMA_K
  #undef DMA_V
  #undef CMASK
  #undef CBIAS
  #undef CBIAS_ON
  #undef CBSUB
  #undef CINIT
  #undef TBP_
  #undef START
  #undef RESC
  #undef ROT
}
constexpr int ATTN_LDS_BYTES=LDS_BYTES;
#undef SBAR
#undef WAIT_BAR
}
#define GAS __attribute__((address_space(1)))
#define LAS __attribute__((address_space(3)))
typedef unsigned short bf16;
typedef unsigned v4u __attribute__((ext_vector_type(4)));
typedef float f32x4 __attribute__((ext_vector_type(4)));
typedef short bf16x8 __attribute__((ext_vector_type(8)));
typedef GAS unsigned gu32;
typedef GAS unsigned long long gu64;
#define RLX_AGENT __ATOMIC_RELAXED, __HIP_MEMORY_SCOPE_AGENT
#define LDS_WAIT() asm volatile("s_waitcnt lgkmcnt(0)" ::: "memory")
#define VM_WAIT() asm volatile("s_waitcnt vmcnt(0)" ::: "memory")
__device__ __forceinline__ unsigned long long rt() { return __builtin_amdgcn_s_memrealtime(); }
__device__ __forceinline__ unsigned f2bf(float f) { unsigned u = __builtin_bit_cast(unsigned, f); return (u + 0x7fffu + ((u >> 16) & 1u)) >> 16; }
__device__ __forceinline__ unsigned pk2(float lo, float hi) { return f2bf(lo) | (f2bf(hi) << 16); }

#define XB_TMO      128
#define XB_XCNT(j)  (256  + 64 * (j))
#define XB_XSUB(j)  (1280 + 64 * (j))
#define XB_XGEN(j)  (2304 + 64 * (j))
#define XB_TOP      3328
#define XB_TOPGEN   3392
#define XCD_BAR_WORDS 3456
#define XB_SPIN_CAP (1u << 18)

__device__ __forceinline__ unsigned xb_ld(unsigned* p)              { return __hip_atomic_load(p, __ATOMIC_RELAXED, __HIP_MEMORY_SCOPE_AGENT); }
__device__ __forceinline__ unsigned xb_add(unsigned* p, unsigned v) { return __hip_atomic_fetch_add(p, v, __ATOMIC_RELAXED, __HIP_MEMORY_SCOPE_AGENT); }
__device__ __forceinline__ unsigned xb_xcc_id() { return (unsigned)__builtin_amdgcn_s_getreg((3 << 11) | 20) & 0xFu; }
#define XB_SPIN(cond, bar) do { unsigned _sp = 0; while (cond) { __builtin_amdgcn_s_sleep(1); \
    if ((++_sp & 255u) == 0u) { if (xb_ld(&(bar)[XB_TMO])) break; if (_sp > XB_SPIN_CAP) { atomicAdd(&(bar)[XB_TMO], 1u); break; } } } } while (0)

struct XcdBarrier {
    unsigned* bar; unsigned x;
    volatile LAS unsigned* st;
};

__device__ __forceinline__ XcdBarrier xcd_barrier_post(unsigned* bar, volatile LAS unsigned* st) {
    XcdBarrier b; b.bar = bar; b.x = xb_xcc_id(); b.st = st;
    if (threadIdx.x == 0) (void)xb_add(&bar[XB_XCNT(b.x)], 1u);
    return b;
}
__device__ __forceinline__ void xcd_barrier_complete(unsigned* bar, unsigned x, unsigned& nloc, unsigned& nx) {
    const unsigned G = gridDim.x * gridDim.y * gridDim.z;
    unsigned sum, cnt, mine, sp = 0u;
    for (;;) {
        sum = 0u; cnt = 0u; mine = 0u;
#pragma unroll
        for (unsigned j = 0; j < 16; ++j) { const unsigned c = xb_ld(&bar[XB_XCNT(j)]); sum += c; cnt += (c > 0u) ? 1u : 0u; mine = (j == x) ? c : mine; }
        if (sum == G) break;
        __builtin_amdgcn_s_sleep(1);
        if ((++sp & 255u) == 0u) { if (xb_ld(&bar[XB_TMO])) break; if (sp > XB_SPIN_CAP) { atomicAdd(&bar[XB_TMO], 1u); break; } }
    }
    nloc = mine > 0u ? mine : 1u; nx = cnt > 0u ? cnt : 1u;
}

__device__ __forceinline__ void xcd_barrier(const XcdBarrier& b) {
    asm volatile("s_waitcnt vmcnt(0)" ::: "memory");
    __syncthreads();
    if (threadIdx.x == 0) {
        unsigned* bar = b.bar;
        __builtin_amdgcn_s_waitcnt(0);
        unsigned nloc = b.st[0], nx = b.st[1];
        if (nloc == 0u) { xcd_barrier_complete(bar, b.x, nloc, nx); b.st[0] = nloc; b.st[1] = nx; }
        const unsigned old = xb_add(&bar[XB_XSUB(b.x)], 1u);
        const unsigned gen = old / nloc;
        if (old + 1u == (gen + 1u) * nloc) {
            __builtin_amdgcn_fence(__ATOMIC_RELEASE, "agent");
            asm volatile("s_waitcnt vmcnt(0)" ::: "memory");
            const unsigned og = xb_add(&bar[XB_TOP], 1u);
            const unsigned tg = og / nx;
            if (og + 1u == (tg + 1u) * nx) xb_add(&bar[XB_TOPGEN], 1u);
            else XB_SPIN(xb_ld(&bar[XB_TOPGEN]) == tg, bar);
            __builtin_amdgcn_fence(__ATOMIC_ACQUIRE, "agent");
            xb_add(&bar[XB_XGEN(b.x)], 1u);
            asm volatile("s_waitcnt vmcnt(0)" ::: "memory");
        } else {
            XB_SPIN(xb_ld(&bar[XB_XGEN(b.x)]) == gen, bar);
            __builtin_amdgcn_fence(__ATOMIC_ACQUIRE, "agent");
            asm volatile("s_waitcnt vmcnt(0)" ::: "memory");
        }
    }
    __syncthreads();
}
namespace mk {
using pg8::bf16_t; using pg8::f32x4; using pg8::u32x4; using pg8::bf16x8; using pg8::Unit;
typedef float f32x16 __attribute__((ext_vector_type(16)));
typedef float f32x2 __attribute__((ext_vector_type(2)));
typedef unsigned u32x2 __attribute__((ext_vector_type(2)));
typedef LAS unsigned char* ldsp_t;

constexpr int DM = 2048, NB = 4, SEQ = 2048, DB = 8, PAST = 16384, PAGE = 128, NPAGES = 128;
constexpr int NH = 8, NG = 64, DFF = 5504, DFF2 = 11008, INW = 8192;
constexpr int MP = NB * SEQ, MT = MP + DB, MPAD = MP + 16;
constexpr float LN_EPS = 1e-5f, ALPHA = 1.189207115002721f, LOG2E = 1.4426950408889634f, C2 = 0.125f * 1.4426950408889634f;
constexpr int NWAVES = 8, NTHREADS = 512;

constexpr size_t MiB = 1u << 20;
constexpr size_t WS_CTL = 0, CTL_ZERO_BYTES = 1 * MiB;
constexpr size_t WS_WIN = 2 * MiB, WS_WGLU = 34 * MiB, WS_WPA = 36 * MiB, WS_WPS = 40 * MiB, WS_WOUT = 44 * MiB, WS_WUP = 52 * MiB, WS_WDOWN = 96 * MiB;
constexpr size_t WS_XB = 118 * MiB, WS_Q = 152 * MiB, WS_K = 168 * MiB, WS_V = 184 * MiB, WS_U = 200 * MiB, WS_GA = 216 * MiB, WS_GS = 248 * MiB;
constexpr size_t WS_O0 = 280 * MiB, WS_O1 = 296 * MiB, WS_ATT = 312 * MiB, WS_G = 330 * MiB, WS_SSM = 348 * MiB, WS_MA = 366 * MiB, WS_MG = 430 * MiB;
constexpr size_t WS_S1 = 464 * MiB, WS_HF = 530 * MiB, WS_HB = 596 * MiB, WS_ACT = 630 * MiB, WS_S2 = 718 * MiB, WS_UPF = 784 * MiB, WS_UPL = 796 * MiB;
constexpr size_t WS_KT = 808 * MiB, WS_BPOW = 810 * MiB, WS_CPOW = 826 * MiB, WS_SMALL = 842 * MiB, WS_DPART = 850 * MiB, WS_FAST_END = 856 * MiB;
constexpr int SM_LAM = 0, SM_TB = 64  , SM_ABAR = 2048  , SM_ABART = SM_ABAR + 8192, SM_BB = SM_ABART + 8192  , SM_ZS = SM_BB + 131072  ,
              SM_GS = SM_ZS + 65536  , SM_MAS = SM_GS + 8192  , SM_S1S = SM_MAS + 16384, SM_HFS = SM_S1S + 16384, SM_UPS = SM_HFS + 16384  ,
              SM_S2S = SM_UPS + 88064, SM_END = SM_S2S + 16384;
static_assert((size_t)SM_END * 4 <= 8 * MiB, "small region");
constexpr int CW_TMO = 0, CW_BAR = 4096;

constexpr int RING_BYTES = 131072, LDSCTL_OFF = RING_BYTES, MISC_OFF = LDSCTL_OFF + 320, LDS_BYTES = 147456;

struct Args { const void* in[35]; float* out; unsigned char* ws; int ph_lo, ph_hi; };

struct Frame { ldsp_t lds; int tid, lane, wave, bid, vcu, G; };

__device__ __forceinline__ unsigned pk2(float lo, float hi) { typedef __bf16 bf2 __attribute__((ext_vector_type(2))); f32x2 v = {lo, hi}; bf2 b = __builtin_convertvector(v, bf2); return __builtin_bit_cast(unsigned, b); }
__device__ __forceinline__ float bf_lo(unsigned w) { return __uint_as_float(w << 16); }
__device__ __forceinline__ float bf_hi(unsigned w) { return __uint_as_float(w & 0xffff0000u); }
__device__ __forceinline__ float bf1(bf16_t h) { return __uint_as_float((unsigned)h << 16); }
__device__ __forceinline__ bf16_t f2bf(float f) { return (bf16_t)(pk2(f, 0.f) & 0xffffu); }
__device__ __forceinline__ float fast_sigmoid(float x) { return __builtin_amdgcn_rcpf(1.f + __builtin_amdgcn_exp2f(-LOG2E * x)); }
__device__ __forceinline__ float gelu_tanh_f(float x) { const float u = 0.7978845608028654f * (x + 0.044715f * x * x * x); const float e = __builtin_amdgcn_exp2f(-2.f * LOG2E * u); return x * __builtin_amdgcn_rcpf(1.f + e); }
__device__ __forceinline__ float wave_sum(float v) {
#pragma unroll
    for (int o = 1; o < 64; o <<= 1) v += __shfl_xor(v, o);
    return v;
}
__device__ __forceinline__ void wg_bar() { asm volatile("s_waitcnt vmcnt(0) lgkmcnt(0)" ::: "memory"); __builtin_amdgcn_s_barrier(); asm volatile("" ::: "memory"); }

struct EpiIn {
    static constexpr bool PERM = true, AFTER_DRAIN = false;
    bf16_t *Q, *K, *V, *U, *GA, *GS; float *outK, *outV;
    __device__ __forceinline__ void operator()(const f32x4 (&acc)[2][2][4][2], const Unit& u, int wr, int wc, int fr, int fq) const {
        const int ct = u.pn; bf16_t* base; int ldc, colt, mode = 0; float* fo = nullptr;
        if (ct < 4) { base = Q; ldc = 1024; colt = ct * 256; mode = 1; }
        else if (ct < 8) { base = K; ldc = 1024; colt = (ct - 4) * 256; fo = outK; }
        else if (ct < 12) { base = V; ldc = 1024; colt = (ct - 8) * 256; fo = outV; }
        else if (ct < 16) { base = U; ldc = 1024; colt = (ct - 12) * 256; }
        else if (ct < 24) { base = GA; ldc = 2048; colt = (ct - 16) * 256; mode = 2; }
        else { base = GS; ldc = 2048; colt = (ct - 24) * 256; mode = 2; }
        const int row0 = u.pm * 256 + wr * 64 + fr, col0 = colt + wc * 32 + 8 * fq;
#pragma unroll
        for (int ai = 0; ai < 2; ++ai)
#pragma unroll
            for (int m = 0; m < 4; ++m) { const size_t row = (size_t)(row0 + ai * 128 + m * 16);
#pragma unroll
                for (int bj = 0; bj < 2; ++bj) { f32x4 v0 = acc[ai][bj][m][0], v1 = acc[ai][bj][m][1];
                    if (fo) { *(f32x4*)(fo + row * 1024 + col0 + bj * 128) = v0; *(f32x4*)(fo + row * 1024 + col0 + bj * 128 + 4) = v1; }
                    if (mode == 1) { v0 = v0 * C2; v1 = v1 * C2; }
                    else if (mode == 2) {
#pragma unroll
                        for (int k = 0; k < 4; ++k) { v0[k] = fast_sigmoid(v0[k]); v1[k] = fast_sigmoid(v1[k]); } }
                    u32x4 w; w.x = pk2(v0[0], v0[1]); w.y = pk2(v0[2], v0[3]); w.z = pk2(v1[0], v1[1]); w.w = pk2(v1[2], v1[3]);
                    *(u32x4*)(base + row * ldc + col0 + bj * 128) = w; } }
    }
};
struct EpiGlu {
    static constexpr bool PERM = true, AFTER_DRAIN = false;
    const bf16_t* G; bf16_t* O;
    __device__ __forceinline__ void operator()(const f32x4 (&acc)[2][2][4][2], const Unit& u, int wr, int wc, int fr, int fq) const {
        const int row0 = u.pm * 256 + wr * 64 + fr, col0 = u.pn * 256 + wc * 32 + 8 * fq;
#pragma unroll
        for (int ai = 0; ai < 2; ++ai)
#pragma unroll
            for (int m = 0; m < 4; ++m) { const size_t off = (size_t)(row0 + ai * 128 + m * 16) * 1024 + col0;
#pragma unroll
                for (int bj = 0; bj < 2; ++bj) { const f32x4 v0 = acc[ai][bj][m][0], v1 = acc[ai][bj][m][1]; const u32x4 g = *(const u32x4*)(G + off + bj * 128); u32x4 w;
                    w.x = pk2(bf_lo(g.x) * fast_sigmoid(v0[0]), bf_hi(g.x) * fast_sigmoid(v0[1])); w.y = pk2(bf_lo(g.y) * fast_sigmoid(v0[2]), bf_hi(g.y) * fast_sigmoid(v0[3]));
                    w.z = pk2(bf_lo(g.z) * fast_sigmoid(v1[0]), bf_hi(g.z) * fast_sigmoid(v1[1])); w.w = pk2(bf_lo(g.w) * fast_sigmoid(v1[2]), bf_hi(g.w) * fast_sigmoid(v1[3]));
                    *(u32x4*)(O + off + bj * 128) = w; } }
    }
};
template <int SECOND> struct EpiProj {
    static constexpr bool PERM = true, AFTER_DRAIN = false;
    const bf16_t* gate; float* MA; bf16_t* MG;
    __device__ __forceinline__ void operator()(const f32x4 (&acc)[2][2][4][2], const Unit& u, int wr, int wc, int fr, int fq) const {
        const int row0 = u.pm * 256 + wr * 64 + fr, col0 = u.pn * 256 + wc * 32 + 8 * fq;
#pragma unroll
        for (int ai = 0; ai < 2; ++ai)
#pragma unroll
            for (int m = 0; m < 4; ++m) { const size_t off = (size_t)(row0 + ai * 128 + m * 16) * 2048 + col0;
#pragma unroll
                for (int bj = 0; bj < 2; ++bj) { f32x4 v0 = acc[ai][bj][m][0], v1 = acc[ai][bj][m][1]; const u32x4 g = *(const u32x4*)(gate + off + bj * 128);
                    v0[0] *= bf_lo(g.x); v0[1] *= bf_hi(g.x); v0[2] *= bf_lo(g.y); v0[3] *= bf_hi(g.y); v1[0] *= bf_lo(g.z); v1[1] *= bf_hi(g.z); v1[2] *= bf_lo(g.w); v1[3] *= bf_hi(g.w);
                    if (!SECOND) { *(f32x4*)(MA + off + bj * 128) = v0; *(f32x4*)(MA + off + bj * 128 + 4) = v1; }
                    else { v0 += *(const f32x4*)(MA + off + bj * 128); v1 += *(const f32x4*)(MA + off + bj * 128 + 4);
                        u32x4 w; w.x = pk2(v0[0], v0[1]); w.y = pk2(v0[2], v0[3]); w.z = pk2(v1[0], v1[1]); w.w = pk2(v1[2], v1[3]); *(u32x4*)(MG + off + bj * 128) = w; } } }
    }
};
struct EpiRes {
    static constexpr bool PERM = false, AFTER_DRAIN = false;
    const float* R; float* O;
    __device__ __forceinline__ void operator()(const f32x4 (&acc)[2][2][4][2], const Unit& u, int wr, int wc, int fr, int fq) const {
        const int row0 = u.pm * 256 + wr * 64 + fr, col0 = u.pn * 256 + wc * 32 + 4 * fq;
#pragma unroll
        for (int ai = 0; ai < 2; ++ai)
#pragma unroll
            for (int m = 0; m < 4; ++m) { const size_t off = (size_t)(row0 + ai * 128 + m * 16) * 2048 + col0;
#pragma unroll
                for (int bj = 0; bj < 2; ++bj)
#pragma unroll
                    for (int n = 0; n < 2; ++n) { const f32x4 r = *(const f32x4*)(R + off + bj * 128 + n * 16); *(f32x4*)(O + off + bj * 128 + n * 16) = r * ALPHA + acc[ai][bj][m][n]; } }
    }
};
#define DPPF(oldv, src, ctrl) __builtin_bit_cast(float, __builtin_amdgcn_update_dpp(__builtin_bit_cast(int, (float)(oldv)), __builtin_bit_cast(int, (float)(src)), (ctrl), 0xf, 0xf, false))
struct EpiUp {
    static constexpr bool PERM = true, AFTER_DRAIN = false;
    const float *cw, *cb; bf16_t* ACT; float *UPF, *UPL;
    __device__ __forceinline__ void operator()(const f32x4 (&acc)[2][2][4][2], const Unit& u, int wr, int wc, int fr, int fq) const {
        const int ch0 = u.pn * 128 + wc * 32 + 8 * fq;
#pragma unroll
        for (int ai = 0; ai < 2; ++ai) {
            const int bnd = u.pm * 4 + ai * 2 + wr; const int rowb = bnd * 64;
#pragma unroll
            for (int bj = 0; bj < 2; ++bj)
#pragma unroll
                for (int n = 0; n < 2; ++n) { const int oc = bj * DFF + ch0 + 4 * n;
                    if (fr < 2) *(f32x4*)(UPF + (size_t)(bnd * 2 + fr) * DFF2 + oc) = acc[ai][bj][0][n];
                    if (fr >= 14) *(f32x4*)(UPL + (size_t)(bnd * 2 + (fr - 14)) * DFF2 + oc) = acc[ai][bj][3][n]; }
#pragma unroll
            for (int n = 0; n < 2; ++n) {
                asm volatile("" ::: "memory");
                f32x4 res[2][4];
#pragma unroll
                for (int bj = 0; bj < 2; ++bj) { const int oc = bj * DFF + ch0 + 4 * n;
                    const f32x4 w0 = *(const f32x4*)(cw + oc), w1 = *(const f32x4*)(cw + DFF2 + oc), w2 = *(const f32x4*)(cw + 2 * DFF2 + oc), bb = *(const f32x4*)(cb + oc);
#pragma unroll
                    for (int m = 0; m < 4; ++m) { const f32x4 cur = acc[ai][bj][m][n], prv = acc[ai][bj][m == 0 ? 0 : m - 1][n]; f32x4 p1, p2;
#pragma unroll
                        for (int k = 0; k < 4; ++k) { const float r1 = DPPF(0.f, prv[k], 0x121), r2 = DPPF(0.f, prv[k], 0x122); p1[k] = DPPF(r1, cur[k], 0x111); p2[k] = DPPF(r2, cur[k], 0x112); }
                        res[bj][m] = bb + w0 * p2 + w1 * p1 + w2 * cur; }
                    asm volatile("" : "+v"(res[bj][0]), "+v"(res[bj][1]), "+v"(res[bj][2]), "+v"(res[bj][3])); }
#pragma unroll
                for (int m = 0; m < 4; ++m) { f32x4 a;
#pragma unroll
                    for (int k = 0; k < 4; ++k) { const float g = res[0][m][k]; a[k] = g * fast_sigmoid(g) * res[1][m][k]; }
                    u32x2 o; o.x = pk2(a[0], a[1]); o.y = pk2(a[2], a[3]);
                    if (!(m == 0 && fr < 2)) *(u32x2*)(ACT + (size_t)(rowb + m * 16 + fr) * DFF + ch0 + 4 * n) = o; }
            }
        }
    }
};

template <class Epi> __device__ __forceinline__ void skinny_gemm(Frame& F, const bf16_t* A16, const bf16_t* Bt, int N, int K, const Epi& E) {
    LAS float* red = (LAS float*)F.lds;
    const int nks = K / 32, l15 = F.lane & 15, kq = F.lane >> 4;
    for (int it = F.bid; it < N / 16; it += F.G) {
        f32x4 acc = {0.f, 0.f, 0.f, 0.f};
        const bf16_t* ap = A16 + (size_t)l15 * K + 8 * kq; const bf16_t* bp = Bt + (size_t)(it * 16 + l15) * K + 8 * kq;
#pragma unroll 4
        for (int ks = F.wave; ks < nks; ks += 8) { const bf16x8 a = *(const bf16x8*)(ap + ks * 32), b = *(const bf16x8*)(bp + ks * 32); acc = __builtin_amdgcn_mfma_f32_16x16x32_bf16(a, b, acc, 0, 0, 0); }
        if (F.lane < 32) {
#pragma unroll
            for (int i = 0; i < 4; ++i) red[(F.wave * 8 + kq * 4 + i) * 16 + l15] = acc[i]; }
        wg_bar();
        if (F.tid < 128) { const int row = F.tid >> 4, col = F.tid & 15; float s = 0.f;
#pragma unroll
            for (int w = 0; w < 8; ++w) s += red[(w * 8 + row) * 16 + col];
            E(row, it * 16 + col, s); }
        wg_bar();
    }
}

__device__ __forceinline__ void p0_transpose_item(const float* W, int K, int N, bf16_t* WT, int drow0, int k0, int n0, LAS float* scr, int lane) {
#pragma unroll 8
    for (int i = 0; i < 32; ++i) { const int kk = 2 * i + (lane >> 5); scr[kk * 33 + (lane & 31)] = W[(size_t)(k0 + kk) * N + n0 + (lane & 31)]; }
    asm volatile("s_waitcnt lgkmcnt(0)" ::: "memory");
    const int c = lane & 7;
#pragma unroll
    for (int j = 0; j < 4; ++j) { const int n = (lane >> 3) + 8 * j; const LAS float* s = scr + (8 * c) * 33 + n;
        u32x4 o; o.x = pk2(s[0 * 33], s[1 * 33]); o.y = pk2(s[2 * 33], s[3 * 33]); o.z = pk2(s[4 * 33], s[5 * 33]); o.w = pk2(s[6 * 33], s[7 * 33]);
        *(u32x4*)(WT + (size_t)(drow0 + n) * K + k0 + 8 * c) = o; }
    asm volatile("s_waitcnt lgkmcnt(0)" ::: "memory");
}
__device__ __forceinline__ int up_perm_row(int c) { return c < DFF ? 256 * (c >> 7) + (c & 127) : 256 * ((c - DFF) >> 7) + 128 + ((c - DFF) & 127); }
__device__ __forceinline__ int up_orig_col(int r) { const int t = r >> 8, j = r & 255; return j < 128 ? 128 * t + j : DFF + 128 * t + (j - 128); }

__device__ __forceinline__ void s5_tables_item(Frame& F, int g, int qtr, const float* a_re, const float* a_im, const float* log_dt, const float* b_re, const float* b_im, const float* c_re, const float* c_im,
                                               const float* dvec, bf16_t* Kt, bf16_t* Bpow, bf16_t* Cpow, float* sm) {
    LAS float* bbl = (LAS float*)F.lds; LAS float* cl = bbl + 2048; LAS float* pw = cl + 2048;
    if (F.tid < 64) { const int p = F.tid;
        const double dt = exp((double)log_dt[g]), ar = a_re[g * 64 + p], ai = a_im[g * 64 + p], mag = exp(ar * dt), ang = ai * dt, abr = mag * cos(ang), abi = mag * sin(ang);
        const double den = ar * ar + ai * ai, fr = ((abr - 1.0) * ar + abi * ai) / den, fi = (abi * ar - (abr - 1.0) * ai) / den;
        for (int ch = 0; ch < 16; ++ch) { const double br = b_re[(g * 64 + p) * 16 + ch], bi = b_im[(g * 64 + p) * 16 + ch]; const float xr = (float)(fr * br - fi * bi), xi = (float)(fr * bi + fi * br);
            bbl[(p * 16 + ch) * 2] = xr; bbl[(p * 16 + ch) * 2 + 1] = xi; if (qtr == 0) { sm[SM_BB + ((g * 64 + p) * 16 + ch) * 2] = xr; sm[SM_BB + ((g * 64 + p) * 16 + ch) * 2 + 1] = xi; } }
        for (int c = 0; c < 16; ++c) { cl[(c * 64 + p) * 2] = c_re[(g * 16 + c) * 64 + p]; cl[(c * 64 + p) * 2 + 1] = c_im[(g * 16 + c) * 64 + p]; }
        double pr = 1.0, pi = 0.0;
        for (int l = 0; l <= 64; ++l) { pw[(p * 66 + l) * 2] = (float)pr; pw[(p * 66 + l) * 2 + 1] = (float)pi; const double nr = pr * abr - pi * abi, ni = pr * abi + pi * abr; pr = nr; pi = ni; }
        if (qtr == 0) { sm[SM_ABAR + (g * 64 + p) * 2] = (float)abr; sm[SM_ABAR + (g * 64 + p) * 2 + 1] = (float)abi; sm[SM_ABART + (g * 64 + p) * 2] = pw[(p * 66 + 64) * 2]; sm[SM_ABART + (g * 64 + p) * 2 + 1] = pw[(p * 66 + 64) * 2 + 1]; }
    }
    wg_bar();
    for (int k = 0; k < 8; ++k) { const int idx = F.tid + 512 * k, l = 16 * qtr + (idx >> 8), c = (idx >> 4) & 15, ch = idx & 15; float s = 0.f;
        for (int p = 0; p < 64; ++p) { const float cr = cl[(c * 64 + p) * 2], ci = cl[(c * 64 + p) * 2 + 1], pr = pw[(p * 66 + l) * 2], pi = pw[(p * 66 + l) * 2 + 1];
            const float er = cr * pr - ci * pi, ei = cr * pi + ci * pr; s += er * bbl[(p * 16 + ch) * 2] - ei * bbl[(p * 16 + ch) * 2 + 1]; }
        if (l == 0 && c == ch) s += dvec[16 * g + c];
        Kt[((size_t)(g * 64 + l) * 16 + c) * 16 + ch] = f2bf(s); }
    for (int k = 0; k < 64; ++k) { const int idx = F.tid + 512 * k, p = 16 * qtr + (idx >> 11), part = (idx >> 10) & 1, jc = idx & 1023, j = jc >> 4, ch = jc & 15;
        const float pr = pw[(p * 66 + 63 - j) * 2], pi = pw[(p * 66 + 63 - j) * 2 + 1], br = bbl[(p * 16 + ch) * 2], bi = bbl[(p * 16 + ch) * 2 + 1];
        Bpow[((size_t)g * 128 + part * 64 + p) * 1024 + jc] = f2bf(part ? pr * bi + pi * br : pr * br - pi * bi); }
    for (int k = 0; k < 64; ++k) { const int idx = F.tid + 512 * k, i = 16 * qtr + (idx >> 11), c = (idx >> 7) & 15, kk = idx & 127, p = kk & 63;
        const float cr = cl[(c * 64 + p) * 2], ci = cl[(c * 64 + p) * 2 + 1], pr = pw[(p * 66 + i + 1) * 2], pi = pw[(p * 66 + i + 1) * 2 + 1];
        Cpow[((size_t)g * 1024 + i * 16 + c) * 128 + kk] = f2bf(kk < 64 ? cr * pr - ci * pi : -(cr * pi + ci * pr)); }
    wg_bar();
}

#define MFMA32(a, b, c) __builtin_amdgcn_mfma_f32_32x32x16_bf16((a), (b), (c), 0, 0, 0)
__device__ __forceinline__ int crow(int r, int hi) { return (r & 3) + 8 * (r >> 2) + 4 * hi; }
__device__ __forceinline__ void s5_unit(Frame& F, int b, int g, const bf16_t* Ub, const bf16_t* Kt, const bf16_t* Bpow, const bf16_t* Cpow, const float* sm, bf16_t* Gb, float* out_re, float* out_im) {
    LAS bf16_t* Ul = (LAS bf16_t*)F.lds;
    LAS bf16_t* Kl = (LAS bf16_t*)(F.lds + 65536);
    LAS float* Gs = (LAS float*)(F.lds + 98304);
    LAS bf16_t* Hl = (LAS bf16_t*)(F.lds + 114688);
    const int r32 = F.lane & 31, hi = F.lane >> 5, w = F.wave;
#pragma unroll
    for (int i = 0; i < 8; ++i) { const int idx = F.tid + 512 * i, ts = idx >> 1, hf = idx & 1, col = ts >> 6, j = ts & 63;
        const u32x4 v = *(const u32x4*)(Ub + (size_t)(b * SEQ + ts) * 1024 + 16 * g + 8 * hf); *(LAS u32x4*)(Ul + ((j * 32 + col) * 16 + 8 * hf)) = v; }
#pragma unroll
    for (int i = 0; i < 4; ++i) { const int idx = F.tid + 512 * i; *(LAS u32x4*)(Kl + idx * 8) = *(const u32x4*)(Kt + (size_t)g * 16384 + idx * 8); }
    wg_bar();
    { const int mt = w & 3, kh = w >> 2; f32x16 acc = {};
      const bf16_t* ap = Bpow + ((size_t)g * 128 + 32 * mt + r32) * 1024 + 8 * hi;
#pragma unroll 4
      for (int js = 0; js < 32; ++js) { const int j = kh * 32 + js; const bf16x8 a = *(const bf16x8*)(ap + j * 16); const bf16x8 bf = *(const LAS bf16x8*)(Ul + ((j * 32 + r32) * 16 + 8 * hi)); acc = MFMA32(a, bf, acc); }
      if (kh == 0) {
#pragma unroll
          for (int i = 0; i < 16; ++i) Gs[(32 * mt + crow(i, hi)) * 32 + r32] = acc[i]; }
      wg_bar();
      if (kh == 1) {
#pragma unroll
          for (int i = 0; i < 16; ++i) Gs[(32 * mt + crow(i, hi)) * 32 + r32] += acc[i]; }
      wg_bar(); }
    if (w == 0) { const int p = F.lane; const float ar = sm[SM_ABART + (g * 64 + p) * 2], ai = sm[SM_ABART + (g * 64 + p) * 2 + 1]; float hr = 0.f, hi_ = 0.f;
        for (int col = 0; col < 32; ++col) { Hl[col * 128 + p] = f2bf(hr); Hl[col * 128 + 64 + p] = f2bf(hi_);
            const float gr = Gs[p * 32 + col], gi = Gs[(64 + p) * 32 + col]; const float nr = ar * hr - ai * hi_ + gr, ni = ar * hi_ + ai * hr + gi; hr = nr; hi_ = ni; }
        out_re[(b * NG + g) * 64 + p] = hr; out_im[(b * NG + g) * 64 + p] = hi_; }
    wg_bar();
#pragma unroll 1
    for (int q = 0; q < 4; ++q) { const int mt = (q == 0) ? w : (q == 1) ? 15 - w : (q == 2) ? 16 + w : 31 - w; f32x16 acc = {};
        const int il = r32 >> 4, c = r32 & 15; const int nj = 2 * mt + 2;
#pragma unroll 2
        for (int j = 0; j < nj; ++j) { const int lag = 2 * mt + il - j; bf16x8 a = {0, 0, 0, 0, 0, 0, 0, 0};
            if (lag >= 0) a = *(const LAS bf16x8*)(Kl + ((lag * 16 + c) * 16 + 8 * hi));
            const bf16x8 bf = *(const LAS bf16x8*)(Ul + ((j * 32 + r32) * 16 + 8 * hi)); acc = MFMA32(a, bf, acc); }
        const bf16_t* cp = Cpow + ((size_t)g * 1024 + 32 * mt + r32) * 128 + 8 * hi;
#pragma unroll
        for (int ks = 0; ks < 8; ++ks) { const bf16x8 a = *(const bf16x8*)(cp + ks * 16); const bf16x8 bf = *(const LAS bf16x8*)(Hl + (r32 * 128 + ks * 16 + 8 * hi)); acc = MFMA32(a, bf, acc); }
#pragma unroll
        for (int grp = 0; grp < 4; ++grp) { const int i = 2 * mt + (grp >> 1), c0 = 8 * (grp & 1) + 4 * hi; const size_t tok = (size_t)b * SEQ + 64 * r32 + i;
            u32x2 o; o.x = pk2(gelu_tanh_f(acc[4 * grp]), gelu_tanh_f(acc[4 * grp + 1])); o.y = pk2(gelu_tanh_f(acc[4 * grp + 2]), gelu_tanh_f(acc[4 * grp + 3]));
            *(u32x2*)(Gb + tok * 1024 + 16 * g + c0) = o; } }
    wg_bar();
}

__device__ __forceinline__ void s5_sample_item(Frame& F, int bs, int g, float* sm, const float* st_re, const float* st_im, const float* c_re, const float* c_im, const float* dvec, float* o_re, float* o_im, bf16_t* Gb) {
    const int p = F.lane; const float* zs = sm + SM_ZS + bs * INW + 3072 + 16 * g;
    const float abr = sm[SM_ABAR + (g * 64 + p) * 2], abi = sm[SM_ABAR + (g * 64 + p) * 2 + 1]; const float x0r = st_re[(bs * NG + g) * 64 + p], x0i = st_im[(bs * NG + g) * 64 + p];
    float br = 0.f, bi = 0.f;
#pragma unroll
    for (int ch = 0; ch < 16; ++ch) { const float u = zs[ch]; br += sm[SM_BB + ((g * 64 + p) * 16 + ch) * 2] * u; bi += sm[SM_BB + ((g * 64 + p) * 16 + ch) * 2 + 1] * u; }
    const float xr = abr * x0r - abi * x0i + br, xi = abr * x0i + abi * x0r + bi;
    o_re[(bs * NG + g) * 64 + p] = xr; o_im[(bs * NG + g) * 64 + p] = xi;
    float myy = 0.f;
#pragma unroll
    for (int c = 0; c < 16; ++c) { float y = wave_sum(xr * c_re[(g * 16 + c) * 64 + p] - xi * c_im[(g * 16 + c) * 64 + p]); if (p == c) myy = y; }
    if (p < 16) { const float y = myy + dvec[16 * g + p] * zs[p]; const float gl = gelu_tanh_f(y); sm[SM_GS + bs * 1024 + 16 * g + p] = gl; Gb[(size_t)(MP + bs) * 1024 + 16 * g + p] = f2bf(gl); }
}

#define DPP_ADD(v, ctrl) ((v) + DPPF((v), (v), (ctrl)))
__device__ __forceinline__ float row16_sum(float v) { v = DPP_ADD(v, 0xB1); v = DPP_ADD(v, 0x4E); v = DPP_ADD(v, 0x141); v = DPP_ADD(v, 0x140); return v; }
__device__ __forceinline__ void decode_unit(Frame& F, int bs, int quad, const float* sm, const float* ck, const float* cv, const int* pt, float* dpart) {
    const int lane = F.lane, w = F.wave;
    f32x4 qv[4];
#pragma unroll
    for (int i = 0; i < 4; ++i) qv[i] = *(const f32x4*)(sm + SM_ZS + bs * INW + 4 * (64 * i + lane)) * C2;
    float m[4], l[4]; f32x4 o[4][2];
#pragma unroll
    for (int i = 0; i < 4; ++i) { m[i] = -1e30f; l[i] = 0.f; o[i][0] = (f32x4){0.f, 0.f, 0.f, 0.f}; o[i][1] = (f32x4){0.f, 0.f, 0.f, 0.f}; }
    const int jown = (lane >> 4) & 1;
#pragma unroll 1
    for (int pg = 0; pg < 4; ++pg) { const int pidx = quad * 4 + pg; const int page = pt[bs * NPAGES + pidx];
#pragma unroll 1
        for (int sb = 0; sb < 4; ++sb) {
            f32x4 kv[4][4], vv[4][4];
#pragma unroll
            for (int t = 0; t < 4; ++t) { const size_t tokoff = ((size_t)page * PAGE + w + 8 * (4 * sb + t)) * 1024;
#pragma unroll
                for (int i = 0; i < 4; ++i) { kv[t][i] = __builtin_nontemporal_load((const f32x4*)(ck + tokoff + 4 * (64 * i + lane))); vv[t][i] = __builtin_nontemporal_load((const f32x4*)(cv + tokoff + 4 * (64 * i + lane))); } }
            float s[4][4];
#pragma unroll
            for (int t = 0; t < 4; ++t)
#pragma unroll
                for (int i = 0; i < 4; ++i) { const f32x4 pr = kv[t][i] * qv[i]; s[t][i] = row16_sum((pr[0] + pr[1]) + (pr[2] + pr[3])); }
            if (pidx == NPAGES - 1) {
#pragma unroll
                for (int t = 0; t < 4; ++t) { const int n = PAST - (pidx * PAGE + w + 8 * (4 * sb + t));
                    if (n < 128) {
#pragma unroll
                        for (int i = 0; i < 4; ++i) s[t][i] += sm[SM_TB + ((4 * i + (lane >> 4)) >> 1) * 128 + n]; } } }
            float sc[4], pown[4][4];
#pragma unroll
            for (int i = 0; i < 4; ++i) { const float mx = fmaxf(fmaxf(s[0][i], s[1][i]), fmaxf(s[2][i], s[3][i])); const float mn = fmaxf(m[i], mx); sc[i] = __builtin_amdgcn_exp2f(m[i] - mn); m[i] = mn; float ls = 0.f;
#pragma unroll
                for (int t = 0; t < 4; ++t) { pown[t][i] = __builtin_amdgcn_exp2f(s[t][i] - mn); ls += pown[t][i]; }
                l[i] = l[i] * sc[i] + ls; }
#pragma unroll
            for (int i = 0; i < 4; ++i) { const float so = __shfl_xor(sc[i], 16); const float s0 = jown ? so : sc[i], s1 = jown ? sc[i] : so; o[i][0] = o[i][0] * s0; o[i][1] = o[i][1] * s1;
#pragma unroll
                for (int t = 0; t < 4; ++t) { const float po = __shfl_xor(pown[t][i], 16); const float p0 = jown ? po : pown[t][i], p1 = jown ? pown[t][i] : po; o[i][0] += vv[t][i] * p0; o[i][1] += vv[t][i] * p1; } }
        } }
    LAS float* Ol = (LAS float*)F.lds; LAS float* ml = Ol + 8 * 16 * 128;
#pragma unroll
    for (int i = 0; i < 4; ++i) { const int hj0 = 4 * i + 2 * (lane >> 5);
        *(LAS f32x4*)(Ol + ((w * 16 + hj0) * 128 + 4 * (lane & 31))) = o[i][0]; *(LAS f32x4*)(Ol + ((w * 16 + hj0 + 1) * 128 + 4 * (lane & 31))) = o[i][1];
        if ((lane & 15) == 0) { ml[(w * 16 + 4 * i + (lane >> 4)) * 2] = m[i]; ml[(w * 16 + 4 * i + (lane >> 4)) * 2 + 1] = l[i]; } }
    wg_bar();
    { const int hj = F.tid >> 5, e4 = F.tid & 31; float M = -1e30f;
#pragma unroll
      for (int ww = 0; ww < 8; ++ww) M = fmaxf(M, ml[(ww * 16 + hj) * 2]);
      float L = 0.f; f32x4 O = {0.f, 0.f, 0.f, 0.f};
#pragma unroll
      for (int ww = 0; ww < 8; ++ww) { const float f = __builtin_amdgcn_exp2f(ml[(ww * 16 + hj) * 2] - M); L += ml[(ww * 16 + hj) * 2 + 1] * f; O += *(const LAS f32x4*)(Ol + ((ww * 16 + hj) * 128 + 4 * e4)) * f; }
      float* dp = dpart + ((size_t)(bs * 32 + quad) * 16 + hj) * 132; *(f32x4*)(dp + 4 * e4) = O; if (e4 == 0) { dp[128] = M; dp[129] = L; } }
    wg_bar();
}
__device__ __forceinline__ void decode_combine_item(Frame& F, int bs, int h, const float* sm, const float* dpart, const float* subg, bf16_t* ATT) {
    const int lane = F.lane; const float lam = sm[SM_LAM]; f32x2 res[2];
#pragma unroll
    for (int j = 0; j < 2; ++j) { const int hj = 2 * h + j;
        float sd = 0.f; { const float* zq = sm + SM_ZS + bs * INW + hj * 64; const float* zk = sm + SM_ZS + bs * INW + 1024 + hj * 64; sd = wave_sum(zq[lane] * zk[lane]) * C2 + sm[SM_TB + h * 128 + 0]; }
        float M = sd;
        for (int sp = 0; sp < 32; ++sp) M = fmaxf(M, dpart[((size_t)(bs * 32 + sp) * 16 + hj) * 132 + 128]);
        const float fs = __builtin_amdgcn_exp2f(sd - M); float L = fs; f32x2 O = *(const f32x2*)(sm + SM_ZS + bs * INW + 2048 + h * 128 + 2 * lane) * fs;
        for (int sp = 0; sp < 32; ++sp) { const float* dp = dpart + ((size_t)(bs * 32 + sp) * 16 + hj) * 132; const float f = __builtin_amdgcn_exp2f(dp[128] - M); L += dp[129] * f; O += *(const f32x2*)(dp + 2 * lane) * f; }
        res[j] = O * (1.f / L); }
    const f32x2 d = res[0] - res[1] * lam; const float ss = wave_sum(d[0] * d[0] + d[1] * d[1]); const float r = rsqrtf(ss * (1.f / 128.f) + LN_EPS) * 0.8f;
    *(unsigned*)(ATT + (size_t)(MP + bs) * 1024 + h * 128 + 2 * lane) = pk2(d[0] * r * subg[2 * lane], d[1] * r * subg[2 * lane + 1]);
}
__device__ __forceinline__ void attn_combine_row(Frame& F, int row, const float lam, const bf16_t* O0, const bf16_t* O1, const float* subg, bf16_t* ATT) {
    const int lane = F.lane; const size_t off = (size_t)row * 1024 + lane * 16; float d[16];
#pragma unroll
    for (int q = 0; q < 2; ++q) { const u32x4 a = *(const u32x4*)(O0 + off + 8 * q), b = *(const u32x4*)(O1 + off + 8 * q);
        d[8 * q + 0] = bf_lo(a.x) - lam * bf_lo(b.x); d[8 * q + 1] = bf_hi(a.x) - lam * bf_hi(b.x); d[8 * q + 2] = bf_lo(a.y) - lam * bf_lo(b.y); d[8 * q + 3] = bf_hi(a.y) - lam * bf_hi(b.y);
        d[8 * q + 4] = bf_lo(a.z) - lam * bf_lo(b.z); d[8 * q + 5] = bf_hi(a.z) - lam * bf_hi(b.z); d[8 * q + 6] = bf_lo(a.w) - lam * bf_lo(b.w); d[8 * q + 7] = bf_hi(a.w) - lam * bf_hi(b.w); }
    float ss = 0.f;
#pragma unroll
    for (int k = 0; k < 16; ++k) ss += d[k] * d[k];
    ss += __shfl_xor(ss, 1); ss += __shfl_xor(ss, 2); ss += __shfl_xor(ss, 4);
    const float r = rsqrtf(ss * (1.f / 128.f) + LN_EPS) * 0.8f; const int e0 = (lane & 7) * 16;
#pragma unroll
    for (int q = 0; q < 2; ++q) { u32x4 o; o.x = pk2(d[8 * q] * r * subg[e0 + 8 * q], d[8 * q + 1] * r * subg[e0 + 8 * q + 1]); o.y = pk2(d[8 * q + 2] * r * subg[e0 + 8 * q + 2], d[8 * q + 3] * r * subg[e0 + 8 * q + 3]);
        o.z = pk2(d[8 * q + 4] * r * subg[e0 + 8 * q + 4], d[8 * q + 5] * r * subg[e0 + 8 * q + 5]); o.w = pk2(d[8 * q + 6] * r * subg[e0 + 8 * q + 6], d[8 * q + 7] * r * subg[e0 + 8 * q + 7]);
        *(u32x4*)(ATT + off + 8 * q) = o; }
}
__device__ __forceinline__ void ln_row(Frame& F, const float* x, const float* g, const float* b, float* of, bf16_t* ob) {
    const int lane = F.lane; f32x4 v[8]; float s = 0.f;
#pragma unroll
    for (int j = 0; j < 8; ++j) { v[j] = *(const f32x4*)(x + 4 * (lane + 64 * j)); s += (v[j][0] + v[j][1]) + (v[j][2] + v[j][3]); }
    const float mu = wave_sum(s) * (1.f / DM); float q = 0.f;
#pragma unroll
    for (int j = 0; j < 8; ++j) { v[j] = v[j] - mu; q += (v[j][0] * v[j][0] + v[j][1] * v[j][1]) + (v[j][2] * v[j][2] + v[j][3] * v[j][3]); }
    const float rstd = rsqrtf(wave_sum(q) * (1.f / DM) + LN_EPS);
#pragma unroll
    for (int j = 0; j < 8; ++j) { const int c = 4 * (lane + 64 * j); const f32x4 o = v[j] * rstd * *(const f32x4*)(g + c) + *(const f32x4*)(b + c); *(f32x4*)(of + c) = o;
        if (ob) { u32x2 w; w.x = pk2(o[0], o[1]); w.y = pk2(o[2], o[3]); *(u32x2*)(ob + c) = w; } }
}
}
#ifndef NOBIAS
#define NOBIAS 0
#endif
namespace mk {
__device__ const unsigned char BUCKET[128] = {0, 1, 2, 3, 4, 5, 6, 7, 8, 9, 10, 11, 12, 13, 14, 15, 16, 16, 16, 17, 17, 18, 18, 18, 19, 19, 19, 20, 20, 20, 20, 21, 21, 21, 21, 22, 22, 22, 22, 22, 23, 23, 23, 23, 23, 23, 24, 24, 24, 24, 24, 24, 25, 25, 25, 25, 25, 25, 25, 26, 26, 26, 26, 26, 26, 26, 26, 27, 27, 27, 27, 27, 27, 27, 27, 27, 27, 28, 28, 28, 28, 28, 28, 28, 28, 28, 28, 29, 29, 29, 29, 29, 29, 29, 29, 29, 29, 29, 29, 30, 30, 30, 30, 30, 30, 30, 30, 30, 30, 30, 30, 30, 30, 31, 31, 31, 31, 31, 31, 31, 31, 31, 31, 31, 31, 31, 31, 31};
struct SkZs { float* zs; float* oK; float* oV; __device__ __forceinline__ void operator()(int row, int col, float a) const { zs[row * INW + col] = a; if (col >= 1024 && col < 2048) oK[row * 1024 + col - 1024] = a; else if (col >= 2048 && col < 3072) oV[row * 1024 + col - 2048] = a; } };
struct SkGlu { const float* gs; bf16_t* O; __device__ __forceinline__ void operator()(int row, int col, float a) const { O[(size_t)(MP + row) * 1024 + col] = f2bf(gs[row * 1024 + col] * fast_sigmoid(a)); } };
struct SkPA { const float* zs; float* mas; __device__ __forceinline__ void operator()(int row, int col, float a) const { mas[row * DM + col] = fast_sigmoid(zs[row * INW + 4096 + col]) * a; } };
struct SkPS { const float* zs; const float* mas; bf16_t* MG; __device__ __forceinline__ void operator()(int row, int col, float a) const { MG[(size_t)(MP + row) * DM + col] = f2bf(mas[row * DM + col] + fast_sigmoid(zs[row * INW + 6144 + col]) * a); } };
struct SkRes { const float* R; float* O; __device__ __forceinline__ void operator()(int row, int col, float a) const { O[row * DM + col] = ALPHA * R[row * DM + col] + a; } };
struct SkUp { float* ups; __device__ __forceinline__ void operator()(int row, int col, float a) const { ups[row * DFF2 + up_orig_col(col)] = a; } };

__device__ __forceinline__ int lane_id_fresh() { int l; asm volatile("v_mbcnt_lo_u32_b32 %0, -1, 0\n\tv_mbcnt_hi_u32_b32 %0, -1, %0" : "=v"(l)); return l; }
#define REFRESH_F() do { F.lane = lane_id_fresh(); F.tid = F.wave * 64 + F.lane; } while (0)
typedef const char __attribute__((address_space(4)))* kargp_t;
__device__ __forceinline__ kargp_t karg() { kargp_t p = (kargp_t)__builtin_amdgcn_kernarg_segment_ptr(); asm volatile("" : "+s"(p)); return p; }
#define INP(k) (*(const float* const __attribute__((address_space(4)))*)(karg() + 8 * (k)))
__global__ void __launch_bounds__(NTHREADS, 2) mk_fwd(Args args) {
    extern __shared__ __attribute__((aligned(16))) unsigned char lds_raw[];
    Frame F; F.lds = (ldsp_t)lds_raw; F.tid = threadIdx.x; F.lane = F.tid & 63; F.wave = __builtin_amdgcn_readfirstlane(F.tid >> 6); F.bid = blockIdx.x; F.G = gridDim.x;
    F.vcu = (F.G % 8 == 0) ? (F.bid % 8) * (F.G / 8) + F.bid / 8 : F.bid;
    volatile LAS unsigned* MISC = (volatile LAS unsigned*)(F.lds + MISC_OFF);
    unsigned char* ws = args.ws; unsigned* ctl = (unsigned*)(ws + WS_CTL);
    for (int u = F.tid; u < (LDS_BYTES - LDSCTL_OFF) / 4; u += NTHREADS) ((LAS unsigned*)(F.lds + LDSCTL_OFF))[u] = 0u;
    __syncthreads();
    const int lo = args.ph_lo, hi = args.ph_hi;
    XcdBarrier bar; bar.bar = ctl + CW_BAR; bar.x = 0; bar.st = nullptr;
    if (hi - lo > 1) bar = xcd_barrier_post(ctl + CW_BAR, MISC + 8);
#ifndef PHMASK
#define PHMASK 0x7ff
#endif
#define IN(k) ((((PHMASK) >> (k)) & 1) && lo <= (k) && (k) < hi)
#define SEAM(k) do { if (IN(k) && IN((k) + 1)) xcd_barrier(bar); } while (0)
#define x_prompt INP(0)
#define x_sample INP(1)
#define cache_k INP(2)
#define cache_v INP(3)
#define st_re INP(4)
#define st_im INP(5)
#define st_conv INP(6)
#define page_table ((const int*)INP(7))
#define rel_bias INP(8)
#define subln_g INP(14)
#define ln1_g INP(27)
#define ln1_b INP(28)
#define conv_w INP(30)
#define conv_b INP(31)
#define ln2_g INP(33)
#define ln2_b INP(34)
#define OUTB (args.out)
#define o_yp (OUTB)
#define o_ys (OUTB + (size_t)MP * DM)
#define o_kp (o_ys + (size_t)DB * DM)
#define o_vp (o_kp + (size_t)MP * 1024)
#define o_rep (o_vp + (size_t)MP * 1024)
#define o_imp (o_rep + NB * 4096)
#define o_cp (o_imp + NB * 4096)
#define o_ks (o_cp + (size_t)NB * 2 * DFF2)
#define o_vs (o_ks + DB * 1024)
#define o_res (o_vs + DB * 1024)
#define o_ims (o_res + DB * 4096)
#define o_cs (o_ims + DB * 4096)
#define WIN ((bf16_t*)(ws + WS_WIN))
#define WGLU ((bf16_t*)(ws + WS_WGLU))
#define WPA ((bf16_t*)(ws + WS_WPA))
#define WPS ((bf16_t*)(ws + WS_WPS))
#define WOUT ((bf16_t*)(ws + WS_WOUT))
#define WUP ((bf16_t*)(ws + WS_WUP))
#define WDOWN ((bf16_t*)(ws + WS_WDOWN))
#define XB ((bf16_t*)(ws + WS_XB))
#define Qb ((bf16_t*)(ws + WS_Q))
#define Kb ((bf16_t*)(ws + WS_K))
#define Vb ((bf16_t*)(ws + WS_V))
#define Ub ((bf16_t*)(ws + WS_U))
#define GAb ((bf16_t*)(ws + WS_GA))
#define GSb ((bf16_t*)(ws + WS_GS))
#define O0b ((bf16_t*)(ws + WS_O0))
#define O1b ((bf16_t*)(ws + WS_O1))
#define ATTb ((bf16_t*)(ws + WS_ATT))
#define Gb ((bf16_t*)(ws + WS_G))
#define SSMb ((bf16_t*)(ws + WS_SSM))
#define MA ((float*)(ws + WS_MA))
#define MGb ((bf16_t*)(ws + WS_MG))
#define S1 ((float*)(ws + WS_S1))
#define Hf ((float*)(ws + WS_HF))
#define Hb ((bf16_t*)(ws + WS_HB))
#define ACTb ((bf16_t*)(ws + WS_ACT))
#define S2 ((float*)(ws + WS_S2))
#define UPF ((float*)(ws + WS_UPF))
#define UPL ((float*)(ws + WS_UPL))
#define KT ((bf16_t*)(ws + WS_KT))
#define BPOW ((bf16_t*)(ws + WS_BPOW))
#define CPOW ((bf16_t*)(ws + WS_CPOW))
#define sm ((float*)(ws + WS_SMALL))
#define dpart ((float*)(ws + WS_DPART))
    const int gw = F.vcu * NWAVES + F.wave, NGW = F.G * NWAVES;

    if (IN(0)) {
        for (int it = F.bid; it < 256; it += F.G)
            s5_tables_item(F, it >> 2, it & 3, INP(15), INP(16), INP(17), INP(18), INP(19), INP(20),
                           INP(21), INP(22), KT, BPOW, CPOW, sm);
        if (F.bid == 0) {
            for (int idx = F.tid; idx < 1024; idx += NTHREADS) { const int h = idx >> 7, n = idx & 127; sm[SM_TB + idx] = NOBIAS ? 0.f : (rel_bias[BUCKET[n] * NH + h] - rel_bias[31 * NH + h]) * LOG2E; }
            if (F.tid == 0) { const float* q1 = INP(10); const float* k1 = INP(11); const float* q2 = INP(12); const float* k2 = INP(13);
                float a = 0.f, b = 0.f; for (int i = 0; i < 64; ++i) { a += q1[i] * k1[i]; b += q2[i] * k2[i]; } sm[SM_LAM] = expf(a) - expf(b) + 0.2f; }
        }
        LAS float* scr = (LAS float*)(F.lds + F.wave * 16384);
        const float* Wsrc[7] = {INP(9), INP(23), INP(24), INP(25), INP(26), INP(29), INP(32)};
        bf16_t* Wdst[7] = {WIN, WGLU, WPA, WPS, WOUT, WUP, WDOWN};
        constexpr int WK[7] = {2048, 1024, 1024, 1024, 2048, 2048, 5504}, WN[7] = {8192, 1024, 2048, 2048, 2048, 11008, 2048};
        int it = gw;
#pragma unroll
        for (int mi = 0; mi < 7; ++mi) { const int nblk = WN[mi] / 32, items = (WK[mi] / 64) * nblk;
            for (; it < items; it += NGW) { const int kb = it / nblk, nb = it % nblk, n0 = 32 * nb; p0_transpose_item(Wsrc[mi], WK[mi], WN[mi], Wdst[mi], mi == 5 ? up_perm_row(n0) : n0, 64 * kb, n0, scr, F.lane); }
            it -= items; }
        for (int m = gw; m < MT; m += NGW) { const float* xr = m < MP ? x_prompt + (size_t)m * DM : x_sample + (size_t)(m - MP) * DM; bf16_t* orow = XB + (size_t)m * DM;
#pragma unroll
            for (int j = 0; j < 8; ++j) { const f32x4 v = *(const f32x4*)(xr + 4 * (F.lane + 64 * j)); u32x2 w; w.x = pk2(v[0], v[1]); w.y = pk2(v[2], v[3]); *(u32x2*)(orow + 4 * (F.lane + 64 * j)) = w; } }
    }
    SEAM(0);
    if (IN(1)) { REFRESH_F();
        pg8::Gemm g{XB, WIN, MP, INW, DM}; pg8::StaticOrder S; S.init(MP, INW, F.G, F.bid);
        EpiIn E{Qb, Kb, Vb, Ub, GAb, GSb, o_kp, o_vp};
        pg8::gemm_phase<EpiIn, pg8::StaticOrder, true, true>(F.lds, g, S, E);
        SkZs e{sm + SM_ZS, o_ks, o_vs}; skinny_gemm(F, XB + (size_t)MP * DM, WIN, INW, DM, e);
    }
    SEAM(1);
    if (IN(2)) { REFRESH_F();
#ifndef P2MASK
#define P2MASK 15
#endif
        if (P2MASK & 1) { const int h0 = (((2 * F.vcu) >> 3) & 15) >> 1; LAS float* tbx = (LAS float*)(F.lds + attn_body::LDS_TBX);
            for (int i = F.tid; i < 640; i += NTHREADS) { const int n = i - 256; tbx[i] = (n >= 0 && n < 128) ? sm[SM_TB + h0 * 128 + n] : 0.f; }
            wg_bar(); }
        if (P2MASK & 1) for (int k = 0; k < 2; ++k) { const int pid = 2 * F.vcu + k; if (pid >= 512) break;
            const int s = pid & 3, grp = pid >> 2, vh = grp & 1, hj = (grp >> 1) & 15, b = grp >> 5, h = hj >> 1;
            attn_body::bf16* Oj = (attn_body::bf16*)((hj & 1) ? O1b : O0b);
            attn_body::attn_unit<8>(b, hj * 64, (2 * h + vh) * 64, s, (const attn_body::bf16*)Qb, (const attn_body::bf16*)Kb, (const attn_body::bf16*)Vb, Oj, (char*)lds_raw);
            attn_body::attn_unit<8>(b, hj * 64, (2 * h + vh) * 64, 7 - s, (const attn_body::bf16*)Qb, (const attn_body::bf16*)Kb, (const attn_body::bf16*)Vb, Oj, (char*)lds_raw); }
        REFRESH_F(); wg_bar();
        if (P2MASK & 2) for (int u = F.vcu; u < NB * NG; u += F.G) s5_unit(F, u >> 6, u & 63, Ub, KT, BPOW, CPOW, sm, Gb, o_rep, o_imp);
        if (P2MASK & 4) for (int u = F.vcu; u < DB * 32; u += F.G) decode_unit(F, u >> 5, u & 31, sm, cache_k, cache_v, page_table, dpart);
        if (P2MASK & 8) for (int it = gw; it < DB * NG; it += NGW) s5_sample_item(F, it >> 6, it & 63, sm, st_re, st_im, INP(20), INP(21), INP(22), o_res, o_ims, Gb);
    }
    SEAM(2);
    if (IN(3)) { REFRESH_F();
        const int half = F.G / 2;
        if (F.bid < half) {
            pg8::Gemm g{Gb, WGLU, MP, 1024, 1024}; pg8::StaticOrder S; S.init(MP, 1024, F.G, F.bid); EpiGlu E{Gb, SSMb};
            pg8::gemm_phase<EpiGlu, pg8::StaticOrder, true, true>(F.lds, g, S, E);
        } else {
            const float lam = sm[SM_LAM]; const int tw = (F.bid - half) * NWAVES + F.wave, ntw = (F.G - half) * NWAVES;
            for (int row = tw; row < MP; row += ntw) attn_combine_row(F, row, lam, O0b, O1b, subln_g, ATTb);
            for (int it = tw; it < DB * NH; it += ntw) decode_combine_item(F, it >> 3, it & 7, sm, dpart, subln_g, ATTb);
        }
        wg_bar();
        SkGlu e{sm + SM_GS, SSMb}; skinny_gemm(F, Gb + (size_t)MP * 1024, WGLU, 1024, 1024, e);
    }
    SEAM(3);
    if (IN(4)) { REFRESH_F();
        { pg8::Gemm g{ATTb, WPA, MP, DM, 1024}; pg8::StaticOrder S; S.init(MP, DM, F.G, F.bid); EpiProj<0> E{GAb, MA, MGb};
          pg8::gemm_phase<EpiProj<0>, pg8::StaticOrder, true, true>(F.lds, g, S, E);
          SkPA e{sm + SM_ZS, sm + SM_MAS}; skinny_gemm(F, ATTb + (size_t)MP * 1024, WPA, DM, 1024, e); }
        { pg8::Gemm g{SSMb, WPS, MP, DM, 1024}; pg8::StaticOrder S; S.init(MP, DM, F.G, F.bid); EpiProj<1> E{GSb, MA, MGb};
          pg8::gemm_phase<EpiProj<1>, pg8::StaticOrder, true, true>(F.lds, g, S, E);
          SkPS e{sm + SM_ZS, sm + SM_MAS, MGb}; skinny_gemm(F, SSMb + (size_t)MP * 1024, WPS, DM, 1024, e); }
    }
    SEAM(4);
    if (IN(5)) { REFRESH_F();
        pg8::Gemm g{MGb, WOUT, MP, DM, DM}; pg8::StaticOrder S; S.init(MP, DM, F.G, F.bid); EpiRes E{x_prompt, S1};
        pg8::gemm_phase<EpiRes, pg8::StaticOrder, true, true>(F.lds, g, S, E);
        SkRes e{x_sample, sm + SM_S1S}; skinny_gemm(F, MGb + (size_t)MP * DM, WOUT, DM, DM, e);
    }
    SEAM(5);
    if (IN(6)) { REFRESH_F();
        for (int m = gw; m < MT; m += NGW) { if (m < MP) ln_row(F, S1 + (size_t)m * DM, ln1_g, ln1_b, Hf + (size_t)m * DM, Hb + (size_t)m * DM); else ln_row(F, sm + SM_S1S + (m - MP) * DM, ln1_g, ln1_b, sm + SM_HFS + (m - MP) * DM, Hb + (size_t)m * DM); }
    }
    SEAM(6);
    if (IN(7)) { REFRESH_F();
        pg8::Gemm g{Hb, WUP, MP, DFF2, DM}; pg8::StaticOrder S; S.init(MP, DFF2, F.G, F.bid); EpiUp E{conv_w, conv_b, ACTb, UPF, UPL};
        pg8::gemm_phase<EpiUp, pg8::StaticOrder, true, true>(F.lds, g, S, E);
        SkUp e{sm + SM_UPS}; skinny_gemm(F, Hb + (size_t)MP * DM, WUP, DFF2, DM, e);
    }
    SEAM(7);
    if (IN(8)) { REFRESH_F();
        const int gt = F.vcu * NTHREADS + F.tid, ngt = F.G * NTHREADS;
        for (int idx = gt; idx < 256 * (DFF / 4); idx += ngt) { const int br = idx / (DFF / 4), c = 4 * (idx % (DFF / 4)), bnd = br >> 1, i = br & 1; const bool first = (bnd & 31) == 0; f32x4 r[2];
#pragma unroll
            for (int hh = 0; hh < 2; ++hh) { const int oc = c + hh * DFF; const f32x4 z4 = {0.f, 0.f, 0.f, 0.f};
                const f32x4 cur = *(const f32x4*)(UPF + (size_t)(bnd * 2 + i) * DFF2 + oc);
                const f32x4 l1 = first ? z4 : *(const f32x4*)(UPL + (size_t)((bnd - 1) * 2 + 1) * DFF2 + oc), l0 = first ? z4 : *(const f32x4*)(UPL + (size_t)((bnd - 1) * 2 + 0) * DFF2 + oc);
                const f32x4 p1 = i ? *(const f32x4*)(UPF + (size_t)(bnd * 2) * DFF2 + oc) : l1, p2 = i ? l1 : l0;
                r[hh] = *(const f32x4*)(conv_b + oc) + *(const f32x4*)(conv_w + oc) * p2 + *(const f32x4*)(conv_w + DFF2 + oc) * p1 + *(const f32x4*)(conv_w + 2 * DFF2 + oc) * cur; }
            f32x4 a;
#pragma unroll
            for (int k = 0; k < 4; ++k) a[k] = r[0][k] * fast_sigmoid(r[0][k]) * r[1][k];
            u32x2 w; w.x = pk2(a[0], a[1]); w.y = pk2(a[2], a[3]); *(u32x2*)(ACTb + (size_t)(64 * bnd + i) * DFF + c) = w; }
        for (int idx = gt; idx < NB * 2 * DFF2; idx += ngt) { const int b = idx / (2 * DFF2), rem = idx % (2 * DFF2), i = rem / DFF2, ch = rem % DFF2; o_cp[idx] = UPL[(size_t)((32 * b + 31) * 2 + i) * DFF2 + ch]; }
        for (int idx = gt; idx < DB * DFF; idx += ngt) { const int bs = idx / DFF, c = idx % DFF; float r[2];
#pragma unroll
            for (int hh = 0; hh < 2; ++hh) { const int oc = c + hh * DFF; const float cur = sm[SM_UPS + bs * DFF2 + oc], p2 = st_conv[(size_t)(bs * 2) * DFF2 + oc], p1 = st_conv[(size_t)(bs * 2 + 1) * DFF2 + oc];
                r[hh] = conv_b[oc] + conv_w[oc] * p2 + conv_w[DFF2 + oc] * p1 + conv_w[2 * DFF2 + oc] * cur; o_cs[(size_t)(bs * 2) * DFF2 + oc] = p1; o_cs[(size_t)(bs * 2 + 1) * DFF2 + oc] = cur; }
            ACTb[(size_t)(MP + bs) * DFF + c] = f2bf(r[0] * fast_sigmoid(r[0]) * r[1]); }
    }
    SEAM(8);
    if (IN(9)) { REFRESH_F();
        pg8::Gemm g{ACTb, WDOWN, MP, DM, DFF}; pg8::StaticOrder S; S.init(MP, DM, F.G, F.bid); EpiRes E{Hf, S2};
        pg8::gemm_phase<EpiRes, pg8::StaticOrder, true, true>(F.lds, g, S, E);
        SkRes e{sm + SM_HFS, sm + SM_S2S}; skinny_gemm(F, ACTb + (size_t)MP * DFF, WDOWN, DM, DFF, e);
    }
    SEAM(9);
    if (IN(10)) { REFRESH_F();
        for (int m = gw; m < MT; m += NGW) { if (m < MP) ln_row(F, S2 + (size_t)m * DM, ln2_g, ln2_b, o_yp + (size_t)m * DM, nullptr); else ln_row(F, sm + SM_S2S + (m - MP) * DM, ln2_g, ln2_b, o_ys + (size_t)(m - MP) * DM, nullptr); }
    }
}
#undef INP
#undef IN
#undef SEAM
#undef x_prompt
#undef x_sample
#undef cache_k
#undef cache_v
#undef st_re
#undef st_im
#undef st_conv
#undef page_table
#undef rel_bias
#undef subln_g
#undef ln1_g
#undef ln1_b
#undef conv_w
#undef conv_b
#undef ln2_g
#undef ln2_b
#undef OUTB
#undef o_yp
#undef o_ys
#undef o_kp
#undef o_vp
#undef o_rep
#undef o_imp
#undef o_cp
#undef o_ks
#undef o_vs
#undef o_res
#undef o_ims
#undef o_cs
#undef WIN
#undef WGLU
#undef WPA
#undef WPS
#undef WOUT
#undef WUP
#undef WDOWN
#undef XB
#undef Qb
#undef Kb
#undef Vb
#undef Ub
#undef GAb
#undef GSb
#undef O0b
#undef O1b
#undef ATTb
#undef Gb
#undef SSMb
#undef MA
#undef MGb
#undef S1
#undef Hf
#undef Hb
#undef ACTb
#undef S2
#undef UPF
#undef UPL
#undef KT
#undef BPOW
#undef CPOW
#undef sm
#undef dpart
}
#ifndef MK_DEBUG
#define MK_DEBUG 0
#endif
#ifndef MK_ONE_LAUNCH
#define MK_ONE_LAUNCH 1
#endif
#if MK_DEBUG
namespace dbg {
__global__ void k_cmp(const void* fast, int fbf16, size_t ldf, const float* gold, size_t ldg, int rows, int cols, int tr, float* acc, int k) {
    float e = 0.f, n = 0.f;
    for (size_t i = (size_t)blockIdx.x * blockDim.x + threadIdx.x; i < (size_t)rows * cols; i += (size_t)gridDim.x * blockDim.x) { const size_t r = i / cols, c = i % cols;
        float g = gold[r * ldg + c]; if (tr == 1) g = 1.f / (1.f + expf(-g)); else if (tr == 2) g *= mk::C2;
        const float f = fbf16 ? __uint_as_float((unsigned)((const unsigned short*)fast)[r * ldf + c] << 16) : ((const float*)fast)[r * ldf + c];
        const float d = f - g; e += (d == d) ? d * d : 1e30f; n += g * g; }
    for (int o = 32; o > 0; o >>= 1) { e += __shfl_xor(e, o); n += __shfl_xor(n, o); }
    if ((threadIdx.x & 63) == 0) { atomicAdd(acc + 2 * k, e); atomicAdd(acc + 2 * k + 1, n); }
}
#ifndef MAGA
#define MAGA 0
#endif
#ifndef MAGB
#define MAGB 0
#endif
__global__ void k_encode(const float* acc, int nst, float tol, float* out, const float* out_fast, size_t n) {
    int bad = 0; for (int k = 0; k < nst; ++k) { const float r = acc[2 * k] / fmaxf(acc[2 * k + 1], 1e-30f); if (!(r < tol)) { bad = k + 1; break; } }
    float scale = bad ? (1.f + 0.05f * bad) : 1.f; float X = 0.f;
    if (MAGA > 0) { const float r = acc[2 * (MAGA - 1)] / fmaxf(acc[2 * (MAGA - 1) + 1], 1e-30f); scale = 1.f + sqrtf(fminf(fmaxf(r, 0.f), 4.f)); if (!(r == r)) scale = 4.f; bad = 1; }
    if (MAGB > 0) { const float r = acc[2 * (MAGB - 1)] / fmaxf(acc[2 * (MAGB - 1) + 1], 1e-30f); X = 1.f - log10f(fminf(fmaxf(r, 1e-8f), 1.f)); }
    for (size_t i = (size_t)blockIdx.x * blockDim.x + threadIdx.x; i < n; i += (size_t)gridDim.x * blockDim.x) { float v = bad ? out[i] * scale : out_fast[i]; if (i == 12345 && X > 0.f) v = out[i] + X; out[i] = v; }
}
}
#endif
struct Bump { char* base; size_t off; template <class T> T* take(size_t n) { T* p = (T*)(base + off); off += (n * sizeof(T) + 255) & ~(size_t)255; return p; } };
extern "C" void kernel_launch(void* const* d_in, const int* in_sizes, int n_in, void* d_out, int out_size, void* d_ws, size_t ws_size, hipStream_t stream) {
    using namespace mk;
    static int grid = 0;
    if (grid == 0) {
        int dev = 0, cus = 0, per_cu = 0;
        if (hipGetDevice(&dev) != hipSuccess || hipDeviceGetAttribute(&cus, hipDeviceAttributeMultiprocessorCount, dev) != hipSuccess) { fprintf(stderr, "device query failed\n"); grid = -1; return; }
        if (hipFuncSetAttribute((const void*)mk_fwd, hipFuncAttributeMaxDynamicSharedMemorySize, LDS_BYTES) != hipSuccess) { fprintf(stderr, "hipFuncSetAttribute failed\n"); grid = -1; return; }
        if (hipOccupancyMaxActiveBlocksPerMultiprocessor(&per_cu, (const void*)mk_fwd, NTHREADS, LDS_BYTES) != hipSuccess || per_cu < 1) fprintf(stderr, "occupancy query reports %d\n", per_cu);
        (void)hipGetLastError();
        grid = cus;
        if (n_in != 35 || ws_size < (size_t)2500 * MiB) { fprintf(stderr, "unexpected shapes: n_in %d ws %zu\n", n_in, ws_size); }
    }
    if (grid < 0) return;
    (void)hipMemsetAsync((char*)d_ws + WS_CTL, 0, CTL_ZERO_BYTES, stream);
    Args a{};
    for (int i = 0; i < 35; ++i) a.in[i] = d_in[i];
    a.ws = (unsigned char*)d_ws;
#if MK_DEBUG
    float* out_fast = (float*)((char*)d_ws + (size_t)860 * MiB); a.out = out_fast;
#else
    a.out = (float*)d_out;
#endif
#if MK_ONE_LAUNCH
    a.ph_lo = 0; a.ph_hi = 11; hipLaunchKernelGGL(mk_fwd, dim3(grid), dim3(NTHREADS), LDS_BYTES, stream, a);
#else
    for (int ph = 0; ph < 11; ++ph) { a.ph_lo = ph; a.ph_hi = ph + 1; hipLaunchKernelGGL(mk_fwd, dim3(grid), dim3(NTHREADS), LDS_BYTES, stream, a); }
#endif
#if MK_DEBUG
    {
    using namespace gold;
    const float* x_prompt = (const float*)d_in[0]; const float* x_sample = (const float*)d_in[1]; const float* cache_k = (const float*)d_in[2]; const float* cache_v = (const float*)d_in[3];
    const float* st_re = (const float*)d_in[4]; const float* st_im = (const float*)d_in[5]; const float* st_conv = (const float*)d_in[6]; const int* page_table = (const int*)d_in[7];
    const float* rel_bias = (const float*)d_in[8]; const float* w_in = (const float*)d_in[9];
    const float* lq1 = (const float*)d_in[10]; const float* lk1 = (const float*)d_in[11]; const float* lq2 = (const float*)d_in[12]; const float* lk2 = (const float*)d_in[13];
    const float* subln_g = (const float*)d_in[14]; const float* a_re = (const float*)d_in[15]; const float* a_im = (const float*)d_in[16]; const float* log_dt = (const float*)d_in[17];
    const float* b_re = (const float*)d_in[18]; const float* b_im = (const float*)d_in[19]; const float* c_re = (const float*)d_in[20]; const float* c_im = (const float*)d_in[21];
    const float* ssm_d = (const float*)d_in[22]; const float* w_glu = (const float*)d_in[23]; const float* w_pa = (const float*)d_in[24]; const float* w_ps = (const float*)d_in[25];
    const float* w_out = (const float*)d_in[26]; const float* ln1_g = (const float*)d_in[27]; const float* ln1_b = (const float*)d_in[28]; const float* w_up = (const float*)d_in[29];
    const float* conv_w = (const float*)d_in[30]; const float* conv_b = (const float*)d_in[31]; const float* w_down = (const float*)d_in[32]; const float* ln2_g = (const float*)d_in[33]; const float* ln2_b = (const float*)d_in[34];
    float* out = (float*)d_out;
    float* o_yp = out; float* o_ys = o_yp + (size_t)gold::MP * gold::DM; float* o_kp = o_ys + (size_t)gold::DB * gold::DM; float* o_vp = o_kp + (size_t)gold::MP * 1024; float* o_rep = o_vp + (size_t)gold::MP * 1024;
    float* o_imp = o_rep + gold::NB * 4096; float* o_cp = o_imp + gold::NB * 4096; float* o_ks = o_cp + (size_t)gold::NB * 2 * gold::DFF2; float* o_vs = o_ks + gold::DB * 1024; float* o_res = o_vs + gold::DB * 1024;
    float* o_ims = o_res + gold::DB * 4096; float* o_cs = o_ims + gold::DB * 4096;
    Bump B{(char*)d_ws, (size_t)1000 * mk::MiB};
    const int MT_ = gold::MT, DM_ = gold::DM, INW_ = gold::INW, DFF_ = gold::DFF, DFF2_ = gold::DFF2, MP_ = gold::MP;
    float* lam = B.take<float>(64); float* accb = B.take<float>(256); float* Xall = B.take<float>((size_t)MT_ * DM_); float* Z = B.take<float>((size_t)MT_ * INW_);
    float* O0 = B.take<float>((size_t)MT_ * 1024); float* O1 = B.take<float>((size_t)MT_ * 1024); float* ATT = B.take<float>((size_t)MT_ * 1024);
    float* G = B.take<float>((size_t)MT_ * 1024); float* SSM = B.take<float>((size_t)MT_ * 1024);
    float* MAg = B.take<float>((size_t)MT_ * DM_); float* MG = B.take<float>((size_t)MT_ * DM_); float* S1g = B.take<float>((size_t)MT_ * DM_); float* Hfg = B.take<float>((size_t)MT_ * DM_);
    float* ACT = B.take<float>((size_t)MT_ * DFF_); float* S2g = B.take<float>((size_t)MT_ * DM_);
    float* UP = B.take<float>((size_t)MT_ * DFF2_); float* XRE = UP; float* XIM = UP + (size_t)MT_ * 4096;
    if (B.off > ws_size) { fprintf(stderr, "debug build: workspace too small (%zu > %zu)\n", B.off, ws_size); return; }
    const int MTt = (MT_ + 63) / 64; const float alpha = 1.189207115002721f;
    (void)hipMemsetAsync(accb, 0, 1024, stream);
    hipLaunchKernelGGL(k_concat_x, dim3(2048), dim3(256), 0, stream, x_prompt, x_sample, Xall);
    hipLaunchKernelGGL(k_lam, dim3(1), dim3(64), 0, stream, lq1, lk1, lq2, lk2, lam);
    { Epi e{Z, INW_, nullptr, 0, 0, nullptr, 0, 0, 0.f}; hipLaunchKernelGGL(g_gemm<0>, dim3(INW_ / 64, MTt), dim3(256), 0, stream, Xall, DM_, w_in, MT_, INW_, DM_, e); }
    hipLaunchKernelGGL(k_kv_out, dim3(2048), dim3(256), 0, stream, Z, o_kp, o_vp, o_ks, o_vs);
    hipLaunchKernelGGL(k_attn, dim3(MT_, 16), dim3(128), 0, stream, Z, cache_k, cache_v, page_table, rel_bias, O0, O1);
    hipLaunchKernelGGL(k_attn_comb, dim3(MT_, gold::NH), dim3(128), 0, stream, O0, O1, lam, subln_g, ATT);
    hipLaunchKernelGGL(k_s5_scan, dim3(gold::NG, gold::NB + gold::DB), dim3(64), 0, stream, Z, a_re, a_im, log_dt, b_re, b_im, st_re, st_im, XRE, XIM, o_rep, o_imp, o_res, o_ims);
    hipLaunchKernelGGL(k_s5_out, dim3((MT_ * 1024 + 255) / 256), dim3(256), 0, stream, Z, XRE, XIM, c_re, c_im, ssm_d, G);
    { Epi e{SSM, 1024, G, 1024, 0, nullptr, 0, 0, 0.f}; hipLaunchKernelGGL(g_gemm<1>, dim3(1024 / 64, MTt), dim3(256), 0, stream, G, 1024, w_glu, MT_, 1024, 1024, e); }
    { Epi e{MAg, DM_, Z, INW_, 4096, nullptr, 0, 0, 0.f}; hipLaunchKernelGGL(g_gemm<2>, dim3(DM_ / 64, MTt), dim3(256), 0, stream, ATT, 1024, w_pa, MT_, DM_, 1024, e); }
    { Epi e{MG, DM_, Z, INW_, 6144, MAg, DM_, 0, 0.f}; hipLaunchKernelGGL(g_gemm<3>, dim3(DM_ / 64, MTt), dim3(256), 0, stream, SSM, 1024, w_ps, MT_, DM_, 1024, e); }
    { Epi e{S1g, DM_, Xall, DM_, 0, nullptr, 0, 0, alpha}; hipLaunchKernelGGL(g_gemm<4>, dim3(DM_ / 64, MTt), dim3(256), 0, stream, MG, DM_, w_out, MT_, DM_, DM_, e); }
    hipLaunchKernelGGL(k_ln, dim3(MT_), dim3(256), 0, stream, S1g, ln1_g, ln1_b, Hfg, Hfg + (size_t)MP_ * DM_, MP_);
    { Epi e{UP, DFF2_, nullptr, 0, 0, nullptr, 0, 0, 0.f}; hipLaunchKernelGGL(g_gemm<0>, dim3(DFF2_ / 64, MTt), dim3(256), 0, stream, Hfg, DM_, w_up, MT_, DFF2_, DM_, e); }
    hipLaunchKernelGGL(k_conv, dim3((unsigned)(((size_t)MT_ * DFF_ + 255) / 256)), dim3(256), 0, stream, UP, conv_w, conv_b, st_conv, ACT, o_cp, o_cs);
    { Epi e{S2g, DM_, Hfg, DM_, 0, nullptr, 0, 0, alpha}; hipLaunchKernelGGL(g_gemm<4>, dim3(DM_ / 64, MTt), dim3(256), 0, stream, ACT, DFF_, w_down, MT_, DM_, DFF_, e); }
    hipLaunchKernelGGL(k_ln, dim3(MT_), dim3(256), 0, stream, S2g, ln2_g, ln2_b, o_yp, o_ys, MP_);
    char* w8 = (char*)d_ws; int k = 0; const float* smf = (const float*)(w8 + WS_SMALL);
#define CMP(fast, isbf, ldf, goldp, ldg, rows, cols, tr) do { hipLaunchKernelGGL(dbg::k_cmp, dim3(1024), dim3(256), 0, stream, (const void*)(fast), (isbf), (size_t)(ldf), (const float*)(goldp), (size_t)(ldg), (rows), (cols), (tr), accb, k); ++k; } while (0)
    CMP(w8 + WS_Q, 1, 1024, Z, INW_, MP_, 1024, 2);
    CMP(w8 + WS_K, 1, 1024, Z + 1024, INW_, MP_, 1024, 0);
    CMP(w8 + WS_V, 1, 1024, Z + 2048, INW_, MP_, 1024, 0);
    CMP(w8 + WS_U, 1, 1024, Z + 3072, INW_, MP_, 1024, 0);
    CMP(w8 + WS_GA, 1, 2048, Z + 4096, INW_, MP_, 2048, 1);
    CMP(w8 + WS_GS, 1, 2048, Z + 6144, INW_, MP_, 2048, 1);
    CMP(smf + SM_ZS, 0, INW_, Z + (size_t)MP_ * INW_, INW_, 8, INW_, 0);
    CMP(w8 + WS_O0, 1, 1024, O0, 1024, MP_, 1024, 0);
    CMP(w8 + WS_O1, 1, 1024, O1, 1024, MP_, 1024, 0);
    CMP(w8 + WS_G, 1, 1024, G, 1024, MP_, 1024, 0);
    CMP(out_fast + (o_rep - out), 0, 4096, o_rep, 4096, 8, 4096, 0);
    CMP((const unsigned short*)(w8 + WS_G) + (size_t)MP_ * 1024, 1, 1024, G + (size_t)MP_ * 1024, 1024, 8, 1024, 0);
    CMP(out_fast + (o_res - out), 0, 4096, o_res, 4096, 16, 4096, 0);
    CMP(w8 + WS_ATT, 1, 1024, ATT, 1024, MP_, 1024, 0);
    CMP((const unsigned short*)(w8 + WS_ATT) + (size_t)MP_ * 1024, 1, 1024, ATT + (size_t)MP_ * 1024, 1024, 8, 1024, 0);
    CMP(w8 + WS_SSM, 1, 1024, SSM, 1024, MT_, 1024, 0);
    CMP(w8 + WS_MG, 1, 2048, MG, 2048, MT_, 2048, 0);
    CMP(w8 + WS_S1, 0, 2048, S1g, 2048, MP_, 2048, 0);
    CMP(w8 + WS_HB, 1, 2048, Hfg, 2048, MT_, 2048, 0);
    CMP(w8 + WS_ACT, 1, DFF_, ACT, DFF_, MT_, DFF_, 0);
    CMP(w8 + WS_S2, 0, 2048, S2g, 2048, MP_, 2048, 0);
    CMP(out_fast, 0, 2048, out, 2048, MT_, 2048, 0);
    CMP(out_fast + (o_cp - out), 0, DFF2_, o_cp, DFF2_, 8, DFF2_, 0);
    CMP(out_fast + (o_cs - out), 0, DFF2_, o_cs, DFF2_, 16, DFF2_, 0);
    CMP(out_fast + (o_kp - out), 0, 1024, o_kp, 1024, 2 * MP_, 1024, 0);
    CMP(out_fast + (o_ks - out), 0, 1024, o_ks, 1024, 16, 1024, 0);
    CMP(w8 + WS_O0, 1, 1024, O0, 1024, 256, 1024, 0);
    CMP((const unsigned short*)(w8 + WS_O0) + (size_t)256 * 1024, 1, 1024, O0 + (size_t)256 * 1024, 1024, 256, 1024, 0);
    CMP((const unsigned short*)(w8 + WS_O0) + (size_t)1792 * 1024, 1, 1024, O0 + (size_t)1792 * 1024, 1024, 256, 1024, 0);
    CMP((const unsigned short*)(w8 + WS_O0) + (size_t)512 * 1024, 1, 1024, O0 + (size_t)512 * 1024, 1024, 256, 1024, 0);
    hipLaunchKernelGGL(dbg::k_encode, dim3(2048), dim3(256), 0, stream, accb, 26, 2e-4f, out, out_fast, (size_t)out_size);
    }
#endif
}
```

```cpp
#define MK_DEBUG 0
#define MK_ONE_LAUNCH 1
#define MAGA 0
#define MAGB 0
#define NOBIAS 0
#define ATT_ORIG 4
#define TPA -1
#define TPB -1
#define REP_PH -1
#include <hip/hip_runtime.h>
#include <hip/hip_bf16.h>
#include <cstdio>
#include <cstdint>
#include <cmath>
__device__ __forceinline__ int mk_lane() { int l; asm volatile("v_mbcnt_lo_u32_b32 %0, -1, 0\n\tv_mbcnt_hi_u32_b32 %0, -1, %0" : "=v"(l)); return l; }
__device__ __forceinline__ int mk_tid() { return (__builtin_amdgcn_readfirstlane((int)threadIdx.x) & ~63) + mk_lane(); }
namespace pg8 {
#define PG8_LAS __attribute__((address_space(3)))
typedef unsigned short bf16_t;
typedef short bf16x8 __attribute__((ext_vector_type(8)));
typedef float f32x4 __attribute__((ext_vector_type(4)));
typedef unsigned u32x4 __attribute__((ext_vector_type(4)));
constexpr int BM = 256, BK = 64, HALF = 128, HTB = HALF * BK * 2  , STAGE_BYTES = 8 * HTB, NXCD = 8, WGM = 8;

__host__ __device__ __forceinline__ int lds_byte(int r, int c) { const int st = (r >> 4) * 2 + (c >> 5), rr = r & 15, cc = c & 31, ob = rr * 64 + cc * 2; return st * 1024 + (ob ^ (((ob >> 9) & 1) << 5)); }
__host__ __device__ __forceinline__ void stage_rc(int b, int& R, int& C) { const int st = b / 1024, sb = b % 1024, swz = sb ^ (((sb >> 9) & 1) << 5); R = (st >> 1) * 16 + swz / 64; C = (st & 1) * 32 + (swz % 64) / 2; }
__host__ __device__ __forceinline__ int perm32(int rho) { const int n = rho >> 4, i = rho & 15; return 8 * (i >> 2) + 4 * n + (i & 3); }

struct Unit { int pm, pn; };
struct Gemm { const bf16_t* A; const bf16_t* Bt; int M, N, K; };

struct StaticOrder {
    int nM, nN, nwg, G, c;
    __host__ __device__ void init(int M, int N, int G_, int c_) { nM = M / BM; nN = N / BM; nwg = nM * nN; G = G_; c = c_; }
    __host__ __device__ bool next(int i, Unit& u) const {
        const long L = (long)i * G + c; if (L >= nwg) return false;
        int wgid = (int)L; { const int q = nwg / NXCD, r = nwg % NXCD, xcd = wgid % NXCD, off = wgid / NXCD; wgid = (xcd < r ? xcd * (q + 1) : r * (q + 1) + (xcd - r) * q) + off; }
        const int nig = WGM * nN, gid = wgid / nig, fm = gid * WGM, gsz = (nM - fm) < WGM ? (nM - fm) : WGM;
        u.pm = fm + ((wgid % nig) % gsz); u.pn = (wgid % nig) / gsz; return true;
    }
    __device__ __forceinline__ void a_ready(const Unit&) const {}
    __device__ __forceinline__ void done(const Unit&) const {}
};

__device__ __forceinline__ unsigned cvt_pk_bf16(float lo, float hi) { unsigned r; asm volatile("v_cvt_pk_bf16_f32 %0, %1, %2" : "=v"(r) : "v"(lo), "v"(hi)); return r; }
typedef float f32x2 __attribute__((ext_vector_type(2)));
__device__ __forceinline__ f32x2 gelu_pk(f32x2 v) {
    const f32x2 av = __builtin_elementwise_abs(v), d = av * 0.2316418882f + 1.0f;
    f32x2 t; t.x = __builtin_amdgcn_rcpf(d.x); t.y = __builtin_amdgcn_rcpf(d.y);
    f32x2 q = t * 0.5307027145f + (-0.7265760135f); q = q * t + 0.7107068705f; q = q * t + (-0.142248368f); q = q * t + 0.127414796f; q = q * t;
    const f32x2 s = (v * v) * (-0.72134752044f);
    f32x2 e; e.x = __builtin_amdgcn_exp2f(s.x); e.y = __builtin_amdgcn_exp2f(s.y);
    const f32x2 m = v * (q * e), r = v - m;
    f32x2 o; o.x = v.x < 0.f ? m.x : r.x; o.y = v.y < 0.f ? m.y : r.y; return o;
}

template <int ACT  > struct EpiBf16 {
    static constexpr bool PERM = true, AFTER_DRAIN = false; static_assert(ACT == 0 || ACT == 1, "EpiBf16: ACT is 0 (none) or 1 (gelu_pk)");
    bf16_t* O; int ldc; const float* bias; int split_cols; size_t split_stride; float scale0;
    __device__ __forceinline__ void operator()(const f32x4 (&acc)[2][2][4][2], const Unit& u, int wr, int wc, int fr, int fq) const {
        const int row0 = u.pm * BM + wr * 64 + fr; int colt = u.pn * BM; bf16_t* base = O;
        float sc = 1.f; if (split_cols) { const int t = colt / split_cols; base += (size_t)t * split_stride; colt -= t * split_cols; if (t == 0) sc = scale0; }
        const int col0 = colt + wc * 32 + 8 * fq, bcol0 = u.pn * BM + wc * 32 + 8 * fq;
        f32x4 bv[2][2];
#pragma unroll
        for (int bj = 0; bj < 2; ++bj)
#pragma unroll
            for (int n = 0; n < 2; ++n) bv[bj][n] = bias ? *(const f32x4*)(bias + bcol0 + bj * HALF + 4 * n) : (f32x4){0.f, 0.f, 0.f, 0.f};
#pragma unroll
        for (int ai = 0; ai < 2; ++ai)
#pragma unroll
            for (int m = 0; m < 4; ++m) { bf16_t* rowp = base + (size_t)(row0 + ai * HALF + m * 16) * ldc + col0;
#pragma unroll
                for (int bj = 0; bj < 2; ++bj) { f32x4 v0 = acc[ai][bj][m][0] + bv[bj][0], v1 = acc[ai][bj][m][1] + bv[bj][1];
                    if (ACT == 1) { f32x2 a = gelu_pk((f32x2){v0[0], v0[1]}), b = gelu_pk((f32x2){v0[2], v0[3]}), c = gelu_pk((f32x2){v1[0], v1[1]}), d = gelu_pk((f32x2){v1[2], v1[3]});
                        v0 = (f32x4){a.x, a.y, b.x, b.y}; v1 = (f32x4){c.x, c.y, d.x, d.y}; }
                    v0 = v0 * sc; v1 = v1 * sc; u32x4 w; w.x = cvt_pk_bf16(v0[0], v0[1]); w.y = cvt_pk_bf16(v0[2], v0[3]); w.z = cvt_pk_bf16(v1[0], v1[1]); w.w = cvt_pk_bf16(v1[2], v1[3]);
                    *(u32x4*)(rowp + bj * HALF) = w; } }
    }
};

struct PanelStats {
    unsigned* xbuf;
    unsigned* cnt;
    unsigned* tmo;
    int ntn; float eps;
    unsigned code;
    __device__ __forceinline__ bool run(const f32x4 (&v)[2][2][4][2], const Unit& u, int wr, int wc, int fr, int fq, PG8_LAS unsigned char* lds, int wid, int lane) const {
        typedef float f32x2v __attribute__((ext_vector_type(2)));
        PG8_LAS f32x2v* P = (PG8_LAS f32x2v*)lds;
        PG8_LAS f32x2v* S = (PG8_LAS f32x2v*)(lds + 8192);
        PG8_LAS unsigned* flag = (PG8_LAS unsigned*)(lds + 8192 + 2048);
#pragma unroll
        for (int ai = 0; ai < 2; ++ai)
#pragma unroll
            for (int m = 0; m < 4; ++m) {
                float s = 0.f;
#pragma unroll
                for (int bj = 0; bj < 2; ++bj)
#pragma unroll
                    for (int n = 0; n < 2; ++n) { const f32x4 x = v[ai][bj][m][n]; s += (x[0] + x[1]) + (x[2] + x[3]); }
                s += __shfl_xor(s, 16); s += __shfl_xor(s, 32);
                const float mw = s * (1.0f / 64.0f); float q = 0.f;
#pragma unroll
                for (int bj = 0; bj < 2; ++bj)
#pragma unroll
                    for (int n = 0; n < 2; ++n) { const f32x4 d = v[ai][bj][m][n] - mw; q += (d[0] * d[0] + d[1] * d[1]) + (d[2] * d[2] + d[3] * d[3]); }
                q += __shfl_xor(q, 16); q += __shfl_xor(q, 32);
                if (fq == 0) P[(ai * HALF + wr * 64 + m * 16 + fr) * 4 + wc] = (f32x2v){mw, q};
            }
        asm volatile("s_waitcnt lgkmcnt(0)" ::: "memory"); __builtin_amdgcn_s_barrier(); asm volatile("" ::: "memory");
#if defined(BROKEN_EXCHANGE_NO_WAIT)
#warning BROKEN CONTROL BUILD: the row-statistics exchange does not wait; results are wrong by design
        if (blockIdx.x >= 64) { const long long t0_ = clock64(); while (clock64() - t0_ < 60000) __builtin_amdgcn_s_sleep(8); }
#endif
        const int row = wid * 32 + (lane & 31);
        if (lane < 32) {
            const f32x2v a = P[row * 4 + 0], b = P[row * 4 + 1], c = P[row * 4 + 2], d = P[row * 4 + 3];
            const float mt = (a.x + b.x + c.x + d.x) * 0.25f;
            const float da = a.x - mt, db = b.x - mt, dc = c.x - mt, dd = d.x - mt;
            const float m2 = (a.y + b.y) + (c.y + d.y) + 64.0f * ((da * da + db * db) + (dc * dc + dd * dd));
            unsigned long long* slot = (unsigned long long*)xbuf + ((size_t)(u.pm * BM + row) * 4 + u.pn);
            __hip_atomic_store(slot, ((unsigned long long)__float_as_uint(m2) << 32) | __float_as_uint(mt), __ATOMIC_RELAXED, __HIP_MEMORY_SCOPE_AGENT);
        }
        asm volatile("s_waitcnt vmcnt(0)" ::: "memory");
        if (lane == 0) __hip_atomic_fetch_add(cnt + 64 * u.pm, 1u, __ATOMIC_RELAXED, __HIP_MEMORY_SCOPE_AGENT);
        if (wid == 0) {
            bool dead = false; const unsigned long long t0 = __builtin_amdgcn_s_memrealtime(); const unsigned want = 8u * (unsigned)ntn;
            for (;;) {
#if defined(BROKEN_EXCHANGE_NO_WAIT)
                break;
#endif
                if ((unsigned)__builtin_amdgcn_readfirstlane(__hip_atomic_load(cnt + 64 * u.pm, __ATOMIC_RELAXED, __HIP_MEMORY_SCOPE_AGENT)) >= want) break;
                if (__builtin_amdgcn_s_memrealtime() - t0 > 2000000ull) {
                    if (lane == 0) { unsigned expect = 0u; __hip_atomic_compare_exchange_strong(tmo + 1, &expect, code | (unsigned)(u.pm & 0xff), __ATOMIC_RELAXED, __ATOMIC_RELAXED, __HIP_MEMORY_SCOPE_AGENT);
                                     __hip_atomic_store(tmo, 1u, __ATOMIC_RELAXED, __HIP_MEMORY_SCOPE_AGENT); }
                    dead = true; break; }
                __builtin_amdgcn_s_sleep(2);
            }
            __builtin_amdgcn_fence(__ATOMIC_ACQUIRE, "agent");
            if (lane == 0) flag[0] = dead ? 1u : 0u;
        }
        asm volatile("s_waitcnt vmcnt(0) lgkmcnt(0)" ::: "memory"); __builtin_amdgcn_s_barrier(); asm volatile("" ::: "memory");
        const bool bad = flag[0] != 0u;
        if (lane < 32) {
            const unsigned long long* slot = (const unsigned long long*)xbuf + (size_t)(u.pm * BM + row) * 4; float mt[4], m2[4]; float ms = 0.f;
#pragma unroll
            for (int t = 0; t < 4; ++t) { if (t < ntn) { const unsigned long long w = __hip_atomic_load(slot + t, __ATOMIC_RELAXED, __HIP_MEMORY_SCOPE_AGENT); mt[t] = __uint_as_float((unsigned)w); m2[t] = __uint_as_float((unsigned)(w >> 32)); } else { mt[t] = 0.f; m2[t] = 0.f; } ms += mt[t]; }
            const float mean = ms / (float)ntn; float q = 0.f;
#pragma unroll
            for (int t = 0; t < 4; ++t) if (t < ntn) { const float dm = mt[t] - mean; q += m2[t] + 256.0f * dm * dm; }
            S[row] = (f32x2v){mean, 1.0f / sqrtf(q / (256.0f * (float)ntn) + eps)};
        }
        asm volatile("s_waitcnt lgkmcnt(0)" ::: "memory"); __builtin_amdgcn_s_barrier(); asm volatile("" ::: "memory");
        return bad;
    }
};
struct EpiLnRes {
    static constexpr bool PERM = false, AFTER_DRAIN = true;
    const float* base; float* out; int ldc; const float* bias; PanelStats st; unsigned poison;
    __device__ __forceinline__ void fused(f32x4 (&acc)[2][2][4][2], const Unit& u, int wr, int wc, int fr, int fq, PG8_LAS unsigned char* lds, int wid, int lane) const {
        typedef float f32x2v __attribute__((ext_vector_type(2)));
        const PG8_LAS f32x2v* S = (const PG8_LAS f32x2v*)(lds + 8192);
        const int col0 = u.pn * BM + wc * 32 + 4 * fq;
#pragma unroll
        for (int bj = 0; bj < 2; ++bj)
#pragma unroll
            for (int n = 0; n < 2; ++n) { const f32x4 bv = bias ? *(const f32x4*)(bias + col0 + bj * HALF + n * 16) : (f32x4){0.f, 0.f, 0.f, 0.f};
#pragma unroll
                for (int ai = 0; ai < 2; ++ai)
#pragma unroll
                    for (int m = 0; m < 4; ++m) acc[ai][bj][m][n] += bv; }
        f32x4 pre[4][2][2];
#pragma unroll
        for (int m = 0; m < 4; ++m) { const size_t off = (size_t)(u.pm * BM + wr * 64 + m * 16 + fr) * ldc + col0;
#pragma unroll
            for (int bj = 0; bj < 2; ++bj)
#pragma unroll
                for (int n = 0; n < 2; ++n) pre[m][bj][n] = *(const f32x4*)(base + off + bj * HALF + n * 16); }
        const bool bad = st.run(acc, u, wr, wc, fr, fq, lds, wid, lane) || poison != 0u;
        const float qnan = __builtin_nanf("");
#pragma unroll
        for (int ai = 0; ai < 2; ++ai)
#pragma unroll
            for (int m = 0; m < 4; ++m) { const int r = ai * HALF + wr * 64 + m * 16 + fr; const f32x2v sr = S[r]; const size_t off = (size_t)(u.pm * BM + r) * ldc + col0;
#pragma unroll
                for (int bj = 0; bj < 2; ++bj)
#pragma unroll
                    for (int n = 0; n < 2; ++n) { const f32x4 bs = ai == 0 ? pre[m][bj][n] : *(const f32x4*)(base + off + bj * HALF + n * 16); f32x4 o = bs + (acc[ai][bj][m][n] - sr.x) * sr.y;
                        if (bad) o = (f32x4){qnan, qnan, qnan, qnan}; *(f32x4*)(out + off + bj * HALF + n * 16) = o; }
                if (m & 1) asm volatile("" ::: "memory"); }
    }
};
struct EpiLnResLn {
    static constexpr bool PERM = false, AFTER_DRAIN = true;
    const float* base; float* out; bf16_t* xn; int ldc; const float* bias; PanelStats st1, st2; unsigned poison;
    __device__ __forceinline__ void fused(f32x4 (&acc)[2][2][4][2], const Unit& u, int wr, int wc, int fr, int fq, PG8_LAS unsigned char* lds, int wid, int lane) const {
        typedef float f32x2v __attribute__((ext_vector_type(2))); typedef unsigned u32x2v __attribute__((ext_vector_type(2)));
        const PG8_LAS f32x2v* S = (const PG8_LAS f32x2v*)(lds + 8192);
        const int col0 = u.pn * BM + wc * 32 + 4 * fq;
#pragma unroll
        for (int bj = 0; bj < 2; ++bj)
#pragma unroll
            for (int n = 0; n < 2; ++n) { const f32x4 bv = bias ? *(const f32x4*)(bias + col0 + bj * HALF + n * 16) : (f32x4){0.f, 0.f, 0.f, 0.f};
#pragma unroll
                for (int ai = 0; ai < 2; ++ai)
#pragma unroll
                    for (int m = 0; m < 4; ++m) acc[ai][bj][m][n] += bv; }
        bool bad = st1.run(acc, u, wr, wc, fr, fq, lds, wid, lane) || poison != 0u;
        const float qnan = __builtin_nanf("");
#pragma unroll
        for (int ai = 0; ai < 2; ++ai)
#pragma unroll
            for (int m = 0; m < 4; ++m) { const int r = ai * HALF + wr * 64 + m * 16 + fr; const f32x2v sr = S[r]; const size_t off = (size_t)(u.pm * BM + r) * ldc + col0;
#pragma unroll
                for (int bj = 0; bj < 2; ++bj)
#pragma unroll
                    for (int n = 0; n < 2; ++n) { const f32x4 bs = *(const f32x4*)(base + off + bj * HALF + n * 16); acc[ai][bj][m][n] = bs + (acc[ai][bj][m][n] - sr.x) * sr.y; }
                asm volatile("" : "+v"(acc[ai][0][m][0]), "+v"(acc[ai][0][m][1]), "+v"(acc[ai][1][m][0]), "+v"(acc[ai][1][m][1]));
                if (m & 1) asm volatile("" ::: "memory"); }
        const bool bad1 = bad;
        bad = st2.run(acc, u, wr, wc, fr, fq, lds, wid, lane) || bad;
#pragma unroll
        for (int ai = 0; ai < 2; ++ai)
#pragma unroll
            for (int m = 0; m < 4; ++m) { const int r = ai * HALF + wr * 64 + m * 16 + fr; const f32x2v sr = S[r]; const size_t off = (size_t)(u.pm * BM + r) * ldc + col0;
#pragma unroll
                for (int bj = 0; bj < 2; ++bj)
#pragma unroll
                    for (int n = 0; n < 2; ++n) { const f32x4 x1 = acc[ai][bj][m][n]; *(f32x4*)(out + off + bj * HALF + n * 16) = bad1 ? (f32x4){qnan, qnan, qnan, qnan} : x1;
                        const f32x4 o = (x1 - sr.x) * sr.y; u32x2v w; w.x = cvt_pk_bf16(o[0], o[1]); w.y = cvt_pk_bf16(o[2], o[3]);
                        if (bad) { w.x = 0x7fc07fc0u; w.y = 0x7fc07fc0u; } *(u32x2v*)(xn + off + bj * HALF + n * 16) = w; }
                asm volatile("" ::: "memory"); }
    }
};

template <class Epi, class Sched, bool ALIGN_EPI = false, bool SP2 = false>
__device__ __forceinline__ void gemm_phase(PG8_LAS unsigned char* lds, const Gemm g, const Sched& S, const Epi& E) {
    const int tid = mk_tid(), wid = __builtin_amdgcn_readfirstlane(tid >> 6), lane = tid & 63, wr = wid >> 2, wc = wid & 3, fr = lane & 15, fq = lane >> 4;
    const int K = g.K, nt = K / BK;
    unsigned voffA[2], voffB[2];
#pragma unroll
    for (int i = 0; i < 2; ++i) { int R, C; stage_rc(tid * 16 + i * 8192, R, C); const int Rb = Epi::PERM ? ((R & ~31) + perm32(R & 31)) : R;
        voffA[i] = (unsigned)(R * K + C) * 2u; voffB[i] = (unsigned)(Rb * K + C) * 2u; }
    const size_t kstep = (size_t)(BK * 2);
    const size_t hstep = (size_t)HALF * K * 2;
    const size_t tstep = 2 * hstep;
    const unsigned ldsw = (unsigned)wid * 1024u;
    const int aoff = lds_byte(wr * 64 + fr, fq * 8), boff = lds_byte(wc * 32 + fr, fq * 8);
#define PG8_SA(b, h) (((b) * 2 + (h)) * HTB)
#define PG8_SB(b, h) ((4 + (b) * 2 + (h)) * HTB)
#define PG8_STAGE(bufoff, gbase, voff) do { _Pragma("unroll") for (int _i = 0; _i < 2; ++_i) \
        __builtin_amdgcn_global_load_lds((const unsigned*)((const char*)(gbase) + (voff)[_i]), (PG8_LAS unsigned*)(lds + (bufoff) + ldsw + _i * 8192), 16, 0, 0); } while (0)
#define PG8_LDA(dst, b, h) do { _Pragma("unroll") for (int m = 0; m < 4; ++m) _Pragma("unroll") for (int k = 0; k < 2; ++k) dst[m][k] = *(const PG8_LAS bf16x8*)(lds + PG8_SA(b, h) + aoff + m * 2048 + k * 1024); } while (0)
#define PG8_LDB(dst, b, h) do { _Pragma("unroll") for (int n = 0; n < 2; ++n) _Pragma("unroll") for (int k = 0; k < 2; ++k) dst[n][k] = *(const PG8_LAS bf16x8*)(lds + PG8_SB(b, h) + boff + n * 2048 + k * 1024); } while (0)
#define PG8_MMA(ai, bj, At, Bt) do { __builtin_amdgcn_s_setprio(1); _Pragma("unroll") for (int m = 0; m < 4; ++m) _Pragma("unroll") for (int n = 0; n < 2; ++n) _Pragma("unroll") for (int k = 0; k < 2; ++k) \
        acc[ai][bj][m][n] = __builtin_amdgcn_mfma_f32_16x16x32_bf16(Bt[n][k], At[m][k], acc[ai][bj][m][n], 0, 0, 0); __builtin_amdgcn_s_setprio(0); } while (0)
#define PG8_WAIT_V(n) asm volatile("s_waitcnt vmcnt(" #n ")" ::: "memory")
#define PG8_WAIT_L(n) asm volatile("s_waitcnt lgkmcnt(" #n ")" ::: "memory")
#define PG8_BAR __builtin_amdgcn_s_barrier()
#define PG8_SCHED __builtin_amdgcn_sched_barrier(0)
    Unit cur, nxt; int ui = 0;
    if (!S.next(0, cur)) return;
    f32x4 acc[2][2][4][2];
#pragma unroll
    for (int a = 0; a < 2; ++a)
#pragma unroll
        for (int b = 0; b < 2; ++b)
#pragma unroll
            for (int m = 0; m < 4; ++m)
#pragma unroll
                for (int n = 0; n < 2; ++n) acc[a][b][m][n] = (f32x4){0.f, 0.f, 0.f, 0.f};
    bf16x8 At[4][2], B0[2][2], B1[2][2];
    const char* cA = (const char*)g.A + (size_t)cur.pm * tstep; const char* cB = (const char*)g.Bt + (size_t)cur.pn * tstep;
    S.a_ready(cur);
    if constexpr (SP2) {
        PG8_STAGE(PG8_SB(0, 0), cB, voffB); PG8_STAGE(PG8_SB(0, 1), cB + hstep, voffB); PG8_STAGE(PG8_SA(0, 0), cA, voffA); PG8_STAGE(PG8_SA(0, 1), cA + hstep, voffA);
        if (wr == 1) PG8_BAR;
        PG8_WAIT_V(2); PG8_BAR;
        PG8_STAGE(PG8_SB(1, 0), cB + kstep, voffB); PG8_STAGE(PG8_SA(1, 0), cA + kstep, voffA); PG8_STAGE(PG8_SB(1, 1), cB + hstep + kstep, voffB);
        PG8_WAIT_V(6); PG8_BAR;
    } else {
        PG8_STAGE(PG8_SB(0, 0), cB, voffB); PG8_STAGE(PG8_SA(0, 0), cA, voffA); PG8_STAGE(PG8_SB(0, 1), cB + hstep, voffB); PG8_STAGE(PG8_SA(0, 1), cA + hstep, voffA);
        if (wr == 1) PG8_BAR;
        PG8_WAIT_V(4); PG8_BAR;
        PG8_STAGE(PG8_SB(1, 0), cB + kstep, voffB); PG8_STAGE(PG8_SA(1, 0), cA + kstep, voffA); PG8_STAGE(PG8_SB(1, 1), cB + hstep + kstep, voffB);
        PG8_WAIT_V(6); PG8_BAR;
    }
    for (;;) {
        const bool has_next = S.next(ui + 1, nxt);
        const char* nA = has_next ? (const char*)g.A + (size_t)nxt.pm * tstep : cA; const char* nB = has_next ? (const char*)g.Bt + (size_t)nxt.pn * tstep : cB;
        for (int t = 0; t < nt; t += 2) {
            const bool last = (t == nt - 2);
            const char* a1 = cA + (size_t)(t + 1) * kstep;
            const char* a2 = last ? nA : cA + (size_t)(t + 2) * kstep; const char* b2 = last ? nB : cB + (size_t)(t + 2) * kstep;
            const char* a3 = a2 + kstep; const char* b3 = b2 + kstep;
            if (last && has_next) S.a_ready(nxt);
            if constexpr (SP2) {
            PG8_LDB(B0, 0, 0); PG8_LDB(B1, 0, 1); PG8_SCHED; PG8_LDA(At, 0, 0); PG8_STAGE(PG8_SA(1, 1), a1 + hstep, voffA);
            PG8_WAIT_V(8); PG8_WAIT_L(0); PG8_BAR; PG8_MMA(0, 0, At, B0); PG8_MMA(0, 1, At, B1); PG8_BAR; PG8_SCHED;
            PG8_LDA(At, 0, 1); PG8_STAGE(PG8_SB(0, 0), b2, voffB); PG8_STAGE(PG8_SB(0, 1), b2 + hstep, voffB); PG8_STAGE(PG8_SA(0, 0), a2, voffA);
            PG8_WAIT_V(8); PG8_WAIT_L(0); PG8_BAR; PG8_MMA(1, 0, At, B0); PG8_MMA(1, 1, At, B1); PG8_BAR; PG8_SCHED;
            PG8_LDB(B0, 1, 0); PG8_LDB(B1, 1, 1); PG8_SCHED; PG8_LDA(At, 1, 0); PG8_STAGE(PG8_SA(0, 1), a2 + hstep, voffA);
            PG8_WAIT_V(8); PG8_WAIT_L(0); PG8_BAR; PG8_MMA(0, 0, At, B0); PG8_MMA(0, 1, At, B1); PG8_BAR; PG8_SCHED;
            PG8_LDA(At, 1, 1); PG8_STAGE(PG8_SB(1, 0), b3, voffB); PG8_STAGE(PG8_SB(1, 1), b3 + hstep, voffB); PG8_STAGE(PG8_SA(1, 0), a3, voffA);
            PG8_WAIT_V(8); PG8_WAIT_L(0); PG8_BAR; PG8_MMA(1, 0, At, B0); PG8_MMA(1, 1, At, B1); PG8_BAR; PG8_SCHED;
            } else {
            PG8_LDB(B0, 0, 0); PG8_SCHED; PG8_LDA(At, 0, 0); PG8_STAGE(PG8_SA(1, 1), a1 + hstep, voffA);
            PG8_WAIT_L(8); PG8_BAR; PG8_WAIT_L(0); PG8_MMA(0, 0, At, B0); PG8_BAR; PG8_SCHED;
            PG8_LDB(B1, 0, 1); PG8_STAGE(PG8_SB(0, 0), b2, voffB);
            PG8_BAR; PG8_WAIT_L(0); PG8_MMA(0, 1, At, B1); PG8_BAR;
            PG8_LDA(At, 0, 1); PG8_STAGE(PG8_SA(0, 0), a2, voffA);
            PG8_BAR; PG8_WAIT_L(0); PG8_MMA(1, 0, At, B0); PG8_BAR; PG8_SCHED;
            PG8_STAGE(PG8_SB(0, 1), b2 + hstep, voffB);
            PG8_WAIT_V(6); PG8_BAR; PG8_MMA(1, 1, At, B1); PG8_BAR;
            PG8_LDB(B0, 1, 0); PG8_SCHED; PG8_LDA(At, 1, 0); PG8_STAGE(PG8_SA(0, 1), a2 + hstep, voffA);
            PG8_WAIT_L(8); PG8_BAR; PG8_WAIT_L(0); PG8_MMA(0, 0, At, B0); PG8_BAR; PG8_SCHED;
            PG8_LDB(B1, 1, 1); PG8_STAGE(PG8_SB(1, 0), b3, voffB);
            PG8_BAR; PG8_WAIT_L(0); PG8_MMA(0, 1, At, B1); PG8_BAR;
            PG8_LDA(At, 1, 1); PG8_STAGE(PG8_SA(1, 0), a3, voffA);
            PG8_BAR; PG8_WAIT_L(0); PG8_MMA(1, 0, At, B0); PG8_BAR; PG8_SCHED;
            PG8_STAGE(PG8_SB(1, 1), b3 + hstep, voffB);
            PG8_WAIT_V(6); PG8_BAR; PG8_MMA(1, 1, At, B1); PG8_BAR;
            }
        }
        if constexpr (ALIGN_EPI) { if (wr == 0) PG8_BAR; }
        if constexpr (!Epi::AFTER_DRAIN) { E(acc, cur, wr, wc, fr, fq); S.done(cur); }
        if (!has_next) break;
#pragma unroll
        for (int a = 0; a < 2; ++a)
#pragma unroll
            for (int b = 0; b < 2; ++b)
#pragma unroll
                for (int m = 0; m < 4; ++m)
#pragma unroll
                    for (int n = 0; n < 2; ++n) acc[a][b][m][n] = (f32x4){0.f, 0.f, 0.f, 0.f};
        cur = nxt; cA = nA; cB = nB; ++ui;
        if constexpr (ALIGN_EPI) { if (wr == 1) PG8_BAR; }
    }
    PG8_WAIT_V(0);
    if constexpr (!ALIGN_EPI) { if (wr == 0) PG8_BAR; }
    PG8_BAR;
    if constexpr (Epi::AFTER_DRAIN) { E.fused(acc, cur, wr, wc, fr, fq, lds, wid, lane); S.done(cur); }
#undef PG8_SA
#undef PG8_SB
#undef PG8_STAGE
#undef PG8_LDA
#undef PG8_LDB
#undef PG8_MMA
#undef PG8_WAIT_V
#undef PG8_WAIT_L
#undef PG8_BAR
#undef PG8_SCHED
}
}

#ifndef PG8_SP2
#define PG8_SP2 true
#endif
#ifndef PG8_ALIGN
#define PG8_ALIGN true
#endif
#include <hip/hip_bf16.h>
#include <hip/hip_bf16.h>
#include <cmath>
#ifndef ATT_ORIG
#define ATT_ORIG 0
#endif
namespace attn_body {
using bf16=__hip_bfloat16;
using bf16x8=__attribute__((ext_vector_type(8)))short;
using s16x4=__attribute__((ext_vector_type(4)))short;
using f32x16=__attribute__((ext_vector_type(16)))float;
using u32x4=__attribute__((ext_vector_type(4)))unsigned;
constexpr int BATCH=4,NHEAD=16,SEQ=2048,D=64,DM=NHEAD*D;
constexpr int NW=8,QBLK=32,QB=QBLK*NW,KVBLK=64,NQB=SEQ/QB;
constexpr int ATTN_PITCH=DM, ATTN_UNIT_ROWS=QB;
__device__ __forceinline__ int crow(int r,int hi){return (r&3)+8*(r>>2)+4*hi;}
#define SBAR() __builtin_amdgcn_sched_barrier(0)
__device__ __forceinline__ void cmask(f32x16&p0,f32x16&p1,int jb,int qrel,int hi){
  const float NEG=-INFINITY; int kb=64*jb+4*hi;
  #pragma unroll
  for(int r=0;r<16;++r){int kv=kb+(r&3)+8*(r>>2); if(kv>qrel)p0[r]=NEG; if(kv+32>qrel)p1[r]=NEG;}
}

constexpr int NSLOT=3, SLOTB=8192;
constexpr int LDS_K=0, LDS_V=NSLOT*SLOTB, LDS_WS=2*NSLOT*SLOTB, LDS_OST=LDS_WS+NW*64*4, LDS_TBX=LDS_OST+NW*4096, LDS_BYTES=LDS_TBX+640*4;
constexpr float C2=0.125f*1.4426950408889634f;
__device__ __forceinline__ void glds16(const void*gsrc,unsigned lds_dst){unsigned keep;
  asm volatile("s_mov_b32 %0, m0\n\ts_mov_b32 m0, %2\n\ts_nop 0\n\tglobal_load_lds_dwordx4 %1, off\n\ts_mov_b32 m0, %0":"=&s"(keep):"v"(gsrc),"s"(lds_dst):"memory");}
__device__ __forceinline__ float max3f(float a,float b,float c){float r;asm("v_max3_f32 %0, %1, %2, %3":"=v"(r):"v"(a),"v"(b),"v"(c));return r;}
__device__ __forceinline__ float max2f(float a,float b){float r;asm("v_max_f32_e32 %0, %1, %2":"=v"(r):"v"(a),"v"(b));return r;}
__device__ __forceinline__ float fadd_s(float a,float b){float r;asm("v_add_f32_e32 %0, %1, %2":"=v"(r):"v"(a),"v"(b));return r;}
__device__ __forceinline__ float fsub_s(float a,float b){float r;asm("v_sub_f32_e32 %0, %1, %2":"=v"(r):"v"(a),"v"(b));return r;}
typedef float f32x2_t __attribute__((ext_vector_type(2))); typedef __bf16 bf16x2_t __attribute__((ext_vector_type(2)));
__device__ __forceinline__ unsigned cvtpk_s(float lo,float hi){f32x2_t v={lo,hi};bf16x2_t b=__builtin_convertvector(v,bf16x2_t);return __builtin_bit_cast(unsigned,b);}
#define WAIT_BAR(N) asm volatile("s_waitcnt vmcnt(" #N ") lgkmcnt(0)\n\ts_barrier":::"memory")

__device__ __forceinline__ void qkt(f32x16&p0,f32x16&p1,const char*Kslot,const bf16x8*qr,const f32x16&negm,int r32,int hi){
  const char*kb=Kslot+hi*1024+r32*16;
  #pragma unroll
  for(int d0=0;d0<4;++d0){
    const bf16x8 b0=*reinterpret_cast<const bf16x8*>(kb+d0*2048);
    const bf16x8 b1=*reinterpret_cast<const bf16x8*>(kb+d0*2048+512);
    if(d0==0){p0=__builtin_amdgcn_mfma_f32_32x32x16_bf16(b0,qr[0],negm,0,0,0);p1=__builtin_amdgcn_mfma_f32_32x32x16_bf16(b1,qr[0],negm,0,0,0);}
    else{p0=__builtin_amdgcn_mfma_f32_32x32x16_bf16(b0,qr[d0],p0,0,0,0);p1=__builtin_amdgcn_mfma_f32_32x32x16_bf16(b1,qr[d0],p1,0,0,0);}}
}
typedef __attribute__((address_space(3))) const char* lds_cptr;
typedef short v4i16_t __attribute__((ext_vector_type(4)));
__device__ __forceinline__ void kload8(bf16x8*kf,lds_cptr kp){
  kf[0]=*(const __attribute__((address_space(3))) bf16x8*)(kp);      kf[1]=*(const __attribute__((address_space(3))) bf16x8*)(kp+512);
  kf[2]=*(const __attribute__((address_space(3))) bf16x8*)(kp+2048); kf[3]=*(const __attribute__((address_space(3))) bf16x8*)(kp+2560);
  kf[4]=*(const __attribute__((address_space(3))) bf16x8*)(kp+4096); kf[5]=*(const __attribute__((address_space(3))) bf16x8*)(kp+4608);
  kf[6]=*(const __attribute__((address_space(3))) bf16x8*)(kp+6144); kf[7]=*(const __attribute__((address_space(3))) bf16x8*)(kp+6656);
}
__device__ __forceinline__ void kload2(bf16x8*kf,lds_cptr kp,int j){ kf[2*j]=*(const __attribute__((address_space(3))) bf16x8*)(kp+j*2048); kf[2*j+1]=*(const __attribute__((address_space(3))) bf16x8*)(kp+j*2048+512); }
__device__ __forceinline__ s16x4 vtr(lds_cptr p){ return __builtin_bit_cast(s16x4,__builtin_amdgcn_ds_read_tr16_b64_v4i16((__attribute__((address_space(3))) v4i16_t*)p)); }
__device__ __forceinline__ float rowmax(const f32x16&p0,const f32x16&p1){
  float a=max3f(p0[0],p0[1],p1[0]),b=max3f(p0[2],p0[3],p1[1]);a=max3f(a,p1[2],p1[3]);
  #pragma unroll
  for(int r=4;r<16;r+=4){a=max3f(a,p0[r],p0[r+1]);b=max3f(b,p0[r+2],p0[r+3]);a=max3f(a,p1[r],p1[r+1]);b=max3f(b,p1[r+2],p1[r+3]);}
  const float m=max2f(a,b);
  auto rr=__builtin_amdgcn_permlane32_swap(__float_as_uint(m),__float_as_uint(m),false,false);
  return max2f(__uint_as_float(rr[0]),__uint_as_float(rr[1]));
}
__device__ __forceinline__ void pv(f32x16*o,int vb,bf16x8 pa0,bf16x8 pa1,bf16x8 pa2,bf16x8 pa3){
  #pragma unroll
  for(int d0=0;d0<2;++d0){s16x4 lo[4],hi[4];
    #pragma unroll
    for(int ks=0;ks<4;++ks){
      asm volatile("ds_read_b64_tr_b16 %0,%1 offset:%c2":"=&v"(lo[ks]):"v"(vb),"i"(d0*4096+ks*1024):"memory");
      asm volatile("ds_read_b64_tr_b16 %0,%1 offset:%c2":"=&v"(hi[ks]):"v"(vb),"i"(d0*4096+ks*1024+512):"memory");}
    asm volatile("s_waitcnt lgkmcnt(0)":::"memory");SBAR();
    #define PK(k) (bf16x8){lo[k][0],lo[k][1],lo[k][2],lo[k][3],hi[k][0],hi[k][1],hi[k][2],hi[k][3]}
    o[d0]=__builtin_amdgcn_mfma_f32_32x32x16_bf16(pa0,PK(0),o[d0],0,0,0);
    o[d0]=__builtin_amdgcn_mfma_f32_32x32x16_bf16(pa1,PK(1),o[d0],0,0,0);
    o[d0]=__builtin_amdgcn_mfma_f32_32x32x16_bf16(pa2,PK(2),o[d0],0,0,0);
    o[d0]=__builtin_amdgcn_mfma_f32_32x32x16_bf16(pa3,PK(3),o[d0],0,0,0);
    #undef PK
  }
}

#ifndef ATTN_STORE16
#define ATTN_STORE16(p,v) (*(u32x4*)(p)=(v))
#endif
template<int THRL> __device__ __forceinline__ void attn_unit(int b,int koff,int voff,int qb,const bf16*Q,const bf16*__restrict__ K,const bf16*__restrict__ V,bf16*O,char*shm){
  const int tid=mk_tid(),lane=tid&63,r32=lane&31,hi=lane>>5; const int wid=__builtin_amdgcn_readfirstlane(tid>>6);
  const long rowbase=(long)b*SEQ; const int q0=qb*QB;
  const bf16*Qw=Q+(rowbase+q0+wid*QBLK)*DM+koff;
  const bf16*Kh=K+rowbase*DM+koff,*Vh=V+rowbase*DM+voff;
  const unsigned lds0=(unsigned)(uintptr_t)shm;
  float*wsf=(float*)(shm+LDS_WS)+wid*64;
  const bf16*ksrc=Kh+(long)lane*DM+wid*8;
  const bf16*vsrc=Vh+(long)(16*(wid&3)+(lane>>2))*DM+(wid>>2)*32+(lane&3)*8;
  const unsigned kdst=lds0+LDS_K+wid*1024, vdst=lds0+LDS_V+wid*1024;
  #define DMA_K(t,slot) glds16(ksrc+(long)(t)*KVBLK*DM,(unsigned)__builtin_amdgcn_readfirstlane(kdst+(slot)))
  #define DMA_V(t,slot) glds16(vsrc+(long)(t)*KVBLK*DM,(unsigned)__builtin_amdgcn_readfirstlane(vdst+(slot)))
  const int vb0=(int)(lds0+LDS_V)+((lane>>4)&1)*32+(lane&3)*8+(4*hi+((lane&15)>>2))*64;
  const char*Kbase=shm+LDS_K; bf16x8 kf[8];
  const lds_cptr shm3=(lds_cptr)shm; const lds_cptr kp0=shm3+LDS_K+hi*1024+r32*16; const lds_cptr vp0=shm3+LDS_V+((lane>>4)&1)*32+(lane&3)*8+(4*hi+((lane&15)>>2))*64;
  const int NT=(q0+QB)/KVBLK;
  typedef __attribute__((address_space(3))) float ldsf_t;
  DMA_K(0,0);DMA_V(0,0);DMA_K(1,SLOTB);
  bf16x8 qr[4];
  #pragma unroll
  for(int d0=0;d0<4;++d0)qr[d0]=*reinterpret_cast<const bf16x8*>(&Qw[(long)r32*DM+d0*16+hi*8]);
  float mhat=0.f,l_reg=0.f;f32x16 o[2];o[0]=f32x16{};o[1]=f32x16{};f32x16 negm=f32x16{};asm volatile("":"+v"(negm));
  const int qrel=wid*QBLK+r32;
  #define CMASK(P0,P1,t) do{int jb_=(t)-(NT-4); if(jb_>=0)cmask(P0,P1,jb_,qrel,hi);}while(0)
  #define TBP_(jb) ((const ldsf_t*)(shm3+LDS_TBX)+(256+qx_-64*(jb)))
  #define CBIAS_ON(P0,P1,t) do{int jb_=(t)-(NT-4); if(jb_>=-2){ int qx_=qrel-4*hi; asm volatile("":"+v"(qx_)); const ldsf_t*tp_=TBP_(jb_); \
      _Pragma("unroll") for(int r0_=0;r0_<16;r0_+=8){ _Pragma("unroll") for(int r=r0_;r<r0_+8;++r){const int kr_=(r&3)+8*(r>>2); P0[r]+=tp_[-kr_];} SBAR(); } \
      _Pragma("unroll") for(int r0_=0;r0_<16;r0_+=8){ _Pragma("unroll") for(int r=r0_;r<r0_+8;++r){const int kr_=(r&3)+8*(r>>2); P1[r]+=tp_[-kr_-32];} SBAR(); } } }while(0)
  #define CBSUB(P0,P1,t) do{int jb_=(t)-(NT-4); if(jb_>=-2){ int qx_=qrel-4*hi; asm volatile("":"+v"(qx_)); const ldsf_t*tp_=TBP_(jb_); \
      _Pragma("unroll") for(int r0_=0;r0_<16;r0_+=8){ _Pragma("unroll") for(int r=r0_;r<r0_+8;++r){const int kr_=(r&3)+8*(r>>2); P0[r]+=(tp_[-kr_]-mhat);} SBAR(); } \
      _Pragma("unroll") for(int r0_=0;r0_<16;r0_+=8){ _Pragma("unroll") for(int r=r0_;r<r0_+8;++r){const int kr_=(r&3)+8*(r>>2); P1[r]+=(tp_[-kr_-32]-mhat);} SBAR(); } } \
    else { _Pragma("unroll") for(int r=0;r<16;++r){P0[r]-=mhat;P1[r]-=mhat;} } }while(0)
  #define CINIT(B) ((B)?(f32x16){0.f,0.f,0.f,0.f,0.f,0.f,0.f,0.f,0.f,0.f,0.f,0.f,0.f,0.f,0.f,0.f}:negm)
  #define CBIAS(P0,P1,t) do{ if(!(ATT_ORIG&1)){CBIAS_ON(P0,P1,t);} }while(0)
  bool resc=false;
  #define START(P0,P1) do{ const float rm=rowmax(P0,P1); resc=false; \
    { const float dl=rm; mhat=fadd_s(mhat,dl); \
      _Pragma("unroll") for(int r=0;r<16;++r){P0[r]=fsub_s(P0[r],dl);P1[r]=fsub_s(P1[r],dl);} \
      _Pragma("unroll") for(int r=0;r<16;++r)negm[r]=-mhat; asm volatile("":"+v"(negm)); } \
    _Pragma("unroll") for(int r=0;r<16;++r)P0[r]=__builtin_amdgcn_exp2f(P0[r]); }while(0)
  #define RESC() do{ if(resc){ asm volatile("s_waitcnt lgkmcnt(0)":::"memory"); \
      _Pragma("unroll") for(int d_=0;d_<2;++d_) _Pragma("unroll") for(int r=0;r<16;++r)o[d_][r]*=wsf[crow(r,hi)]; } }while(0)
  f32x16 pA0,pA1,pB0,pB1;
  int sl_prev=0,sl_cur=0,sl_next=SLOTB;
  #define ROT() do{sl_prev=sl_cur;sl_cur=sl_next;sl_next=(sl_next==(NSLOT-1)*SLOTB)?0:sl_next+SLOTB;}while(0)
  DMA_K(2,2*SLOTB);
  WAIT_BAR(3);
  qkt(pA0,pA1,Kbase,qr,negm,r32,hi);asm volatile("s_nop 15\n\ts_nop 7":"+v"(pA0),"+v"(pA1));CBIAS(pA0,pA1,0);CMASK(pA0,pA1,0);
  START(pA0,pA1);
  _Pragma("unroll") for(int r=0;r<16;++r)pA1[r]=__builtin_amdgcn_exp2f(pA1[r]);
  WAIT_BAR(0);
  DMA_K(3,0);DMA_V(1,SLOTB);
  ROT();
  kload8(kf,kp0+sl_cur);
  WAIT_BAR(2);
  s16x4 vlo[8],vhi[8]; u32x4 pw0,pw1,pw2,pw3;
  #define PKW(P,B) cvtpk_s(P[B],P[B+1])
  #define PAF(k) __builtin_bit_cast(bf16x8,pw##k)
  #define VFR(i) (bf16x8){vlo[i][0],vlo[i][1],vlo[i][2],vlo[i][3],vhi[i][0],vhi[i][1],vhi[i][2],vhi[i][3]}
  #define PIN(x) asm volatile("":"+v"(x))
  #define MX3(a,b,c) __builtin_fmaxf(__builtin_fmaxf((a),(b)),(c))
  #define GAPA(MF,A0,A1,A2,A3,W0,W1,PW) do{ MF; sacc+=A0; sacc+=A1; sacc+=A2; sacc+=A3; PIN(sacc); W0; W1; PIN(PW); SBAR(); }while(0)
  #define EX(v) __builtin_amdgcn_exp2f(v)
  #define GAPB(MF,X,B) do{ MF; X[B]=EX(X[B]); X[B+1]=EX(X[B+1]); X[B+2]=EX(X[B+2]); X[B+3]=EX(X[B+3]); PIN(X); SBAR(); }while(0)
  #define VRD(i) do{ vlo[i]=vtr(vp_+(((i)>>2)*4096+((i)&3)*1024)); vhi[i]=vtr(vp_+(((i)>>2)*4096+((i)&3)*1024+512)); }while(0)
  #define KRD(G,j) do{ if(G){ kload2(kf,kp0+sl_next,j); SBAR(); } }while(0)
  #define STEP(C0,C1,P0,P1,t,GK,GV,GL,BAND_) do{ constexpr int BAND=((ATT_ORIG&1)?0:(BAND_)); constexpr int ZC=(ATT_ORIG&4)?0:BAND; SBAR(); \
    const lds_cptr vp_=vp0+sl_prev; \
    VRD(0); SBAR(); float sacc=(P0[0]+P0[1]); \
    GAPA(C0=__builtin_amdgcn_mfma_f32_32x32x16_bf16(kf[0],qr[0],CINIT(ZC),0,0,0), P0[2],P0[3],P0[4],P0[5],     pw0[0]=PKW(P0,0), pw0[1]=PKW(P0,2), pw0); \
    VRD(4); SBAR(); GAPA(C1=__builtin_amdgcn_mfma_f32_32x32x16_bf16(kf[1],qr[0],CINIT(ZC),0,0,0), P0[6],P0[7],P0[8],P0[9],     pw0[2]=PKW(P0,4), pw0[3]=PKW(P0,6), pw0); \
    VRD(1); SBAR(); GAPA(C0=__builtin_amdgcn_mfma_f32_32x32x16_bf16(kf[2],qr[1],C0,0,0,0),   P0[10],P0[11],P0[12],P0[13], pw1[0]=PKW(P0,8), pw1[1]=PKW(P0,10), pw1); \
    VRD(5); SBAR(); GAPA(C1=__builtin_amdgcn_mfma_f32_32x32x16_bf16(kf[3],qr[1],C1,0,0,0),   P0[14],P0[15],P1[0],P1[1],   pw1[2]=PKW(P0,12),pw1[3]=PKW(P0,14), pw1); \
    VRD(2); SBAR(); GAPA(C0=__builtin_amdgcn_mfma_f32_32x32x16_bf16(kf[4],qr[2],C0,0,0,0),   P1[2],P1[3],P1[4],P1[5],     pw2[0]=PKW(P1,0), pw2[1]=PKW(P1,2), pw2); \
    VRD(6); SBAR(); GAPA(C1=__builtin_amdgcn_mfma_f32_32x32x16_bf16(kf[5],qr[2],C1,0,0,0),   P1[6],P1[7],P1[8],P1[9],     pw2[2]=PKW(P1,4), pw2[3]=PKW(P1,6), pw2); \
    VRD(3); SBAR(); GAPA(C0=__builtin_amdgcn_mfma_f32_32x32x16_bf16(kf[6],qr[3],C0,0,0,0),   P1[10],P1[11],P1[12],P1[13], pw3[0]=PKW(P1,8), pw3[1]=PKW(P1,10), pw3); \
    VRD(7); SBAR(); GAPA(C1=__builtin_amdgcn_mfma_f32_32x32x16_bf16(kf[7],qr[3],C1,0,0,0),   P1[14],P1[15],0.f,0.f,       pw3[2]=PKW(P1,12),pw3[3]=PKW(P1,14), pw3); \
    l_reg+=sacc; \
    if(GK){DMA_K((t)+3,sl_cur);} if(GV){DMA_V((t)+1,sl_next);} \
    if(ZC){ CBSUB(C0,C1,t); } else if(BAND){ CBIAS_ON(C0,C1,t); } CMASK(C0,C1,t); \
    { float a=MX3(C0[0],C0[1],C1[0]),b=MX3(C0[2],C0[3],C1[1]); a=MX3(a,C1[2],C1[3]); \
      _Pragma("unroll") for(int r=4;r<16;r+=4){a=MX3(a,C0[r],C0[r+1]);b=MX3(b,C0[r+2],C0[r+3]);a=MX3(a,C1[r],C1[r+1]);b=MX3(b,C1[r+2],C1[r+3]);} \
      float rm=__builtin_fmaxf(a,b); { auto rr=__builtin_amdgcn_permlane32_swap(__float_as_uint(rm),__float_as_uint(rm),false,false); rm=__builtin_fmaxf(__uint_as_float(rr[0]),__uint_as_float(rr[1])); } \
      resc=false; \
      if(__builtin_expect(__any(rm>(float)THRL),0)){ const float dl=__builtin_fmaxf(rm,0.f); mhat+=dl; \
        _Pragma("unroll") for(int r=0;r<16;++r){C0[r]-=dl;C1[r]-=dl;} \
        if(!(ZC)){ _Pragma("unroll") for(int r=0;r<16;++r)negm[r]=-mhat; asm volatile("":"+v"(negm)); } \
        const float f=__builtin_amdgcn_exp2f(-dl); l_reg*=f; if(hi==0)wsf[r32]=f; resc=true; } } \
    SBAR(); \
    GAPB(o[0]=__builtin_amdgcn_mfma_f32_32x32x16_bf16(PAF(0),VFR(0),o[0],0,0,0), C0,0); \
    GAPB(o[1]=__builtin_amdgcn_mfma_f32_32x32x16_bf16(PAF(0),VFR(4),o[1],0,0,0), C0,4); \
    KRD(GL,0); GAPB(o[0]=__builtin_amdgcn_mfma_f32_32x32x16_bf16(PAF(1),VFR(1),o[0],0,0,0), C0,8); \
    KRD(GL,1); GAPB(o[1]=__builtin_amdgcn_mfma_f32_32x32x16_bf16(PAF(1),VFR(5),o[1],0,0,0), C0,12); \
    KRD(GL,2); GAPB(o[0]=__builtin_amdgcn_mfma_f32_32x32x16_bf16(PAF(2),VFR(2),o[0],0,0,0), C1,0); \
    KRD(GL,3); GAPB(o[1]=__builtin_amdgcn_mfma_f32_32x32x16_bf16(PAF(2),VFR(6),o[1],0,0,0), C1,4); \
    GAPB(o[0]=__builtin_amdgcn_mfma_f32_32x32x16_bf16(PAF(3),VFR(3),o[0],0,0,0), C1,8); \
    GAPB(o[1]=__builtin_amdgcn_mfma_f32_32x32x16_bf16(PAF(3),VFR(7),o[1],0,0,0), C1,12); \
    }while(0)
  int t=1;
  #undef CMASK
  #define CMASK(P0,P1,t) do{}while(0)
  #undef CBIAS
  #define CBIAS(P0,P1,t) do{}while(0)
  for(;t+((ATT_ORIG&2)?5:7)<NT;t+=2){
    STEP(pB0,pB1,pA0,pA1,t,true,true,true,0);     WAIT_BAR(2); RESC(); ROT();
    STEP(pA0,pA1,pB0,pB1,t+1,true,true,true,0);   WAIT_BAR(2); RESC(); ROT();
  }
  #undef CMASK
  #define CMASK(P0,P1,t) do{int jb_=(t)-(NT-4); if(jb_>=0)cmask(P0,P1,jb_,qrel,hi);}while(0)
  #undef CBIAS
  #define CBIAS(P0,P1,t) do{ if(!(ATT_ORIG&1)){CBIAS_ON(P0,P1,t);} }while(0)
  #define ENDW(tt) do{ if((tt)+3<NT){WAIT_BAR(2);} else if((tt)+2<NT){WAIT_BAR(1);} else {WAIT_BAR(0);} }while(0)
  for(;t+1<NT;t+=2){
    STEP(pB0,pB1,pA0,pA1,t,(t+3<NT),(t+1<NT),(t+1<NT),1);       ENDW(t);   RESC(); ROT();
    STEP(pA0,pA1,pB0,pB1,t+1,(t+4<NT),(t+2<NT),(t+2<NT),1);     ENDW(t+1); RESC(); ROT();
  }
  STEP(pB0,pB1,pA0,pA1,NT-1,false,false,false,1); RESC();
  { float sacc=pB0[0]+pB0[1]; _Pragma("unroll") for(int r=2;r<16;++r)sacc+=pB0[r]; _Pragma("unroll") for(int r=0;r<16;++r)sacc+=pB1[r]; l_reg+=sacc;
    pw0=(u32x4){PKW(pB0,0),PKW(pB0,2),PKW(pB0,4),PKW(pB0,6)};pw1=(u32x4){PKW(pB0,8),PKW(pB0,10),PKW(pB0,12),PKW(pB0,14)};pw2=(u32x4){PKW(pB1,0),PKW(pB1,2),PKW(pB1,4),PKW(pB1,6)};pw3=(u32x4){PKW(pB1,8),PKW(pB1,10),PKW(pB1,12),PKW(pB1,14)};
    SBAR(); pv(o,vb0+sl_cur,PAF(0),PAF(1),PAF(2),PAF(3)); }
  #undef PKW
  #undef PAF
  #undef VFR
  #undef PIN
  #undef MX3
  #undef GAPA
  #undef GAPB
  #undef EX
  #undef VRD
  #undef KRD
  #undef STEP
  #undef ENDW
  {auto rr=__builtin_amdgcn_permlane32_swap(__float_as_uint(l_reg),__float_as_uint(l_reg),false,false);l_reg=__uint_as_float(rr[0])+__uint_as_float(rr[1]);}
  if(hi==0)wsf[32+r32]=l_reg;asm volatile("s_waitcnt lgkmcnt(0)":::"memory");
  float rli[16];
  #pragma unroll
  for(int r=0;r<16;++r)rli[r]=__builtin_amdgcn_rcpf(wsf[32+crow(r,hi)]);
  bf16*Ow=O+(rowbase+q0+wid*QBLK)*DM+voff;
  { bf16*stg=(bf16*)(shm+LDS_OST)+wid*2048;
    #pragma unroll
    for(int r=0;r<16;++r){const int orow=crow(r,hi);
      #pragma unroll
      for(int d0=0;d0<2;++d0)stg[orow*64+d0*32+r32]=__float2bfloat16(o[d0][r]*rli[r]);}
    asm volatile("s_waitcnt lgkmcnt(0)":::"memory");
    int lnx_; asm volatile("v_mbcnt_lo_u32_b32 %0, -1, 0\n\tv_mbcnt_hi_u32_b32 %0, -1, %0":"=v"(lnx_));
    #pragma unroll
    for(int i=0;i<4;++i){const int row=i*8+(lnx_>>3),ch=lnx_&7; const u32x4 v=*(const u32x4*)(stg+row*64+ch*8); ATTN_STORE16(Ow+(long)row*DM+ch*8,v);} }
  asm volatile("s_waitcnt lgkmcnt(0)\n\ts_barrier":::"memory");
  #undef DMA_K
  #undef DMA_V
  #undef CMASK
  #undef CBIAS
  #undef CBIAS_ON
  #undef CBSUB
  #undef CINIT
  #undef TBP_
  #undef START
  #undef RESC
  #undef ROT
}
constexpr int ATTN_LDS_BYTES=LDS_BYTES;
#undef SBAR
#undef WAIT_BAR
}
#define GAS __attribute__((address_space(1)))
#define LAS __attribute__((address_space(3)))
typedef unsigned short bf16;
typedef unsigned v4u __attribute__((ext_vector_type(4)));
typedef float f32x4 __attribute__((ext_vector_type(4)));
typedef short bf16x8 __attribute__((ext_vector_type(8)));
typedef GAS unsigned gu32;
typedef GAS unsigned long long gu64;
#define RLX_AGENT __ATOMIC_RELAXED, __HIP_MEMORY_SCOPE_AGENT
#define LDS_WAIT() asm volatile("s_waitcnt lgkmcnt(0)" ::: "memory")
#define VM_WAIT() asm volatile("s_waitcnt vmcnt(0)" ::: "memory")
__device__ __forceinline__ unsigned long long rt() { return __builtin_amdgcn_s_memrealtime(); }
__device__ __forceinline__ unsigned f2bf(float f) { unsigned u = __builtin_bit_cast(unsigned, f); return (u + 0x7fffu + ((u >> 16) & 1u)) >> 16; }
__device__ __forceinline__ unsigned pk2(float lo, float hi) { return f2bf(lo) | (f2bf(hi) << 16); }

#define XB_TMO      128
#define XB_XCNT(j)  (256  + 64 * (j))
#define XB_XSUB(j)  (1280 + 64 * (j))
#define XB_XGEN(j)  (2304 + 64 * (j))
#define XB_TOP      3328
#define XB_TOPGEN   3392
#define XCD_BAR_WORDS 3456
#define XB_SPIN_CAP (1u << 18)

__device__ __forceinline__ unsigned xb_ld(unsigned* p)              { return __hip_atomic_load(p, __ATOMIC_RELAXED, __HIP_MEMORY_SCOPE_AGENT); }
__device__ __forceinline__ unsigned xb_add(unsigned* p, unsigned v) { return __hip_atomic_fetch_add(p, v, __ATOMIC_RELAXED, __HIP_MEMORY_SCOPE_AGENT); }
__device__ __forceinline__ unsigned xb_xcc_id() { return (unsigned)__builtin_amdgcn_s_getreg((3 << 11) | 20) & 0xFu; }
#define XB_SPIN(cond, bar) do { unsigned _sp = 0; while (cond) { __builtin_amdgcn_s_sleep(1); \
    if ((++_sp & 255u) == 0u) { if (xb_ld(&(bar)[XB_TMO])) break; if (_sp > XB_SPIN_CAP) { atomicAdd(&(bar)[XB_TMO], 1u); break; } } } } while (0)

struct XcdBarrier {
    unsigned* bar; unsigned x;
    volatile LAS unsigned* st;
};

__device__ __forceinline__ XcdBarrier xcd_barrier_post(unsigned* bar, volatile LAS unsigned* st) {
    XcdBarrier b; b.bar = bar; b.x = xb_xcc_id(); b.st = st;
    if (threadIdx.x == 0) (void)xb_add(&bar[XB_XCNT(b.x)], 1u);
    return b;
}
__device__ __forceinline__ void xcd_barrier_complete(unsigned* bar, unsigned x, unsigned& nloc, unsigned& nx) {
    const unsigned G = gridDim.x * gridDim.y * gridDim.z;
    unsigned sum, cnt, mine, sp = 0u;
    for (;;) {
        sum = 0u; cnt = 0u; mine = 0u;
#pragma unroll
        for (unsigned j = 0; j < 16; ++j) { const unsigned c = xb_ld(&bar[XB_XCNT(j)]); sum += c; cnt += (c > 0u) ? 1u : 0u; mine = (j == x) ? c : mine; }
        if (sum == G) break;
        __builtin_amdgcn_s_sleep(1);
        if ((++sp & 255u) == 0u) { if (xb_ld(&bar[XB_TMO])) break; if (sp > XB_SPIN_CAP) { atomicAdd(&bar[XB_TMO], 1u); break; } }
    }
    nloc = mine > 0u ? mine : 1u; nx = cnt > 0u ? cnt : 1u;
}

__device__ __forceinline__ void xcd_barrier(const XcdBarrier& b) {
    asm volatile("s_waitcnt vmcnt(0)" ::: "memory");
    __syncthreads();
    if (threadIdx.x == 0) {
        unsigned* bar = b.bar;
        __builtin_amdgcn_s_waitcnt(0);
        unsigned nloc = b.st[0], nx = b.st[1];
        if (nloc == 0u) { xcd_barrier_complete(bar, b.x, nloc, nx); b.st[0] = nloc; b.st[1] = nx; }
        const unsigned old = xb_add(&bar[XB_XSUB(b.x)], 1u);
        const unsigned gen = old / nloc;
        if (old + 1u == (gen + 1u) * nloc) {
            __builtin_amdgcn_fence(__ATOMIC_RELEASE, "agent");
            asm volatile("s_waitcnt vmcnt(0)" ::: "memory");
            const unsigned og = xb_add(&bar[XB_TOP], 1u);
            const unsigned tg = og / nx;
            if (og + 1u == (tg + 1u) * nx) xb_add(&bar[XB_TOPGEN], 1u);
            else XB_SPIN(xb_ld(&bar[XB_TOPGEN]) == tg, bar);
            __builtin_amdgcn_fence(__ATOMIC_ACQUIRE, "agent");
            xb_add(&bar[XB_XGEN(b.x)], 1u);
            asm volatile("s_waitcnt vmcnt(0)" ::: "memory");
        } else {
            XB_SPIN(xb_ld(&bar[XB_XGEN(b.x)]) == gen, bar);
            __builtin_amdgcn_fence(__ATOMIC_ACQUIRE, "agent");
            asm volatile("s_waitcnt vmcnt(0)" ::: "memory");
        }
    }
    __syncthreads();
}
namespace mk {
using pg8::bf16_t; using pg8::f32x4; using pg8::u32x4; using pg8::bf16x8; using pg8::Unit;
typedef float f32x16 __attribute__((ext_vector_type(16)));
typedef float f32x2 __attribute__((ext_vector_type(2)));
typedef unsigned u32x2 __attribute__((ext_vector_type(2)));
typedef LAS unsigned char* ldsp_t;

constexpr int DM = 2048, NB = 4, SEQ = 2048, DB = 8, PAST = 16384, PAGE = 128, NPAGES = 128;
constexpr int NH = 8, NG = 64, DFF = 5504, DFF2 = 11008, INW = 8192;
constexpr int MP = NB * SEQ, MT = MP + DB, MPAD = MP + 16;
constexpr float LN_EPS = 1e-5f, ALPHA = 1.189207115002721f, LOG2E = 1.4426950408889634f, C2 = 0.125f * 1.4426950408889634f;
constexpr int NWAVES = 8, NTHREADS = 512;

constexpr size_t MiB = 1u << 20;
constexpr size_t WS_CTL = 0, CTL_ZERO_BYTES = 1 * MiB;
constexpr size_t WS_WIN = 2 * MiB, WS_WGLU = 34 * MiB, WS_WPA = 36 * MiB, WS_WPS = 40 * MiB, WS_WOUT = 44 * MiB, WS_WUP = 52 * MiB, WS_WDOWN = 96 * MiB;
constexpr size_t WS_XB = 118 * MiB, WS_Q = 152 * MiB, WS_K = 168 * MiB, WS_V = 184 * MiB, WS_U = 200 * MiB, WS_GA = 216 * MiB, WS_GS = 248 * MiB;
constexpr size_t WS_O0 = 280 * MiB, WS_O1 = 296 * MiB, WS_ATT = 312 * MiB, WS_G = 330 * MiB, WS_SSM = 348 * MiB, WS_MA = 366 * MiB, WS_MG = 430 * MiB;
constexpr size_t WS_S1 = 464 * MiB, WS_HF = 530 * MiB, WS_HB = 596 * MiB, WS_ACT = 630 * MiB, WS_S2 = 718 * MiB, WS_UPF = 784 * MiB, WS_UPL = 796 * MiB;
constexpr size_t WS_KT = 808 * MiB, WS_BPOW = 810 * MiB, WS_CPOW = 826 * MiB, WS_SMALL = 842 * MiB, WS_DPART = 850 * MiB, WS_FAST_END = 856 * MiB;
constexpr int SM_LAM = 0, SM_TB = 64  , SM_ABAR = 2048  , SM_ABART = SM_ABAR + 8192, SM_BB = SM_ABART + 8192  , SM_ZS = SM_BB + 131072  ,
              SM_GS = SM_ZS + 65536  , SM_MAS = SM_GS + 8192  , SM_S1S = SM_MAS + 16384, SM_HFS = SM_S1S + 16384, SM_UPS = SM_HFS + 16384  ,
              SM_S2S = SM_UPS + 88064, SM_END = SM_S2S + 16384;
static_assert((size_t)SM_END * 4 <= 8 * MiB, "small region");
constexpr int CW_TMO = 0, CW_BAR = 4096;

constexpr int RING_BYTES = 131072, LDSCTL_OFF = 135168, MISC_OFF = LDSCTL_OFF + 320, LDS_BYTES = 147456;

struct Args { const void* in[35]; float* out; unsigned char* ws; int ph_lo, ph_hi; };

struct Frame { ldsp_t lds; int tid, lane, wave, bid, vcu, G; };

__device__ __forceinline__ unsigned pk2(float lo, float hi) { typedef __bf16 bf2 __attribute__((ext_vector_type(2))); f32x2 v = {lo, hi}; bf2 b = __builtin_convertvector(v, bf2); return __builtin_bit_cast(unsigned, b); }
__device__ __forceinline__ float bf_lo(unsigned w) { return __uint_as_float(w << 16); }
__device__ __forceinline__ float bf_hi(unsigned w) { return __uint_as_float(w & 0xffff0000u); }
__device__ __forceinline__ float bf1(bf16_t h) { return __uint_as_float((unsigned)h << 16); }
__device__ __forceinline__ bf16_t f2bf(float f) { return (bf16_t)(pk2(f, 0.f) & 0xffffu); }
__device__ __forceinline__ float fast_sigmoid(float x) { return __builtin_amdgcn_rcpf(1.f + __builtin_amdgcn_exp2f(-LOG2E * x)); }
__device__ __forceinline__ float gelu_tanh_f(float x) { const float u = 0.7978845608028654f * (x + 0.044715f * x * x * x); const float e = __builtin_amdgcn_exp2f(-2.f * LOG2E * u); return x * __builtin_amdgcn_rcpf(1.f + e); }
__device__ __forceinline__ float wave_sum(float v) {
#pragma unroll
    for (int o = 1; o < 64; o <<= 1) v += __shfl_xor(v, o);
    return v;
}
__device__ __forceinline__ void wg_bar() { asm volatile("s_waitcnt vmcnt(0) lgkmcnt(0)" ::: "memory"); __builtin_amdgcn_s_barrier(); asm volatile("" ::: "memory"); }

struct EpiIn {
    static constexpr bool PERM = true, AFTER_DRAIN = false;
    bf16_t *Q, *K, *V, *U, *GA, *GS; float *outK, *outV;
    __device__ __forceinline__ void operator()(const f32x4 (&acc)[2][2][4][2], const Unit& u, int wr, int wc, int fr, int fq) const {
        const int ct = u.pn; bf16_t* base; int ldc, colt, mode = 0; float* fo = nullptr;
        if (ct < 4) { base = Q; ldc = 1024; colt = ct * 256; mode = 1; }
        else if (ct < 8) { base = K; ldc = 1024; colt = (ct - 4) * 256; fo = outK; }
        else if (ct < 12) { base = V; ldc = 1024; colt = (ct - 8) * 256; fo = outV; }
        else if (ct < 16) { base = U; ldc = 1024; colt = (ct - 12) * 256; }
        else if (ct < 24) { base = GA; ldc = 2048; colt = (ct - 16) * 256; mode = 2; }
        else { base = GS; ldc = 2048; colt = (ct - 24) * 256; mode = 2; }
        const int row0 = u.pm * 256 + wr * 64 + fr, col0 = colt + wc * 32 + 8 * fq;
#pragma unroll
        for (int ai = 0; ai < 2; ++ai)
#pragma unroll
            for (int m = 0; m < 4; ++m) { const size_t row = (size_t)(row0 + ai * 128 + m * 16);
#pragma unroll
                for (int bj = 0; bj < 2; ++bj) { f32x4 v0 = acc[ai][bj][m][0], v1 = acc[ai][bj][m][1];
                    if (fo) { *(f32x4*)(fo + row * 1024 + col0 + bj * 128) = v0; *(f32x4*)(fo + row * 1024 + col0 + bj * 128 + 4) = v1; }
                    if (mode == 1) { v0 = v0 * C2; v1 = v1 * C2; }
                    else if (mode == 2) {
#pragma unroll
                        for (int k = 0; k < 4; ++k) { v0[k] = fast_sigmoid(v0[k]); v1[k] = fast_sigmoid(v1[k]); } }
                    u32x4 w; w.x = pk2(v0[0], v0[1]); w.y = pk2(v0[2], v0[3]); w.z = pk2(v1[0], v1[1]); w.w = pk2(v1[2], v1[3]);
                    *(u32x4*)(base + row * ldc + col0 + bj * 128) = w; } }
    }
};
struct EpiGlu {
    static constexpr bool PERM = true, AFTER_DRAIN = false;
    const bf16_t* G; bf16_t* O;
    __device__ __forceinline__ void operator()(const f32x4 (&acc)[2][2][4][2], const Unit& u, int wr, int wc, int fr, int fq) const {
        const int row0 = u.pm * 256 + wr * 64 + fr, col0 = u.pn * 256 + wc * 32 + 8 * fq;
#pragma unroll
        for (int ai = 0; ai < 2; ++ai)
#pragma unroll
            for (int m = 0; m < 4; ++m) { const size_t off = (size_t)(row0 + ai * 128 + m * 16) * 1024 + col0;
#pragma unroll
                for (int bj = 0; bj < 2; ++bj) { const f32x4 v0 = acc[ai][bj][m][0], v1 = acc[ai][bj][m][1]; const u32x4 g = *(const u32x4*)(G + off + bj * 128); u32x4 w;
                    w.x = pk2(bf_lo(g.x) * fast_sigmoid(v0[0]), bf_hi(g.x) * fast_sigmoid(v0[1])); w.y = pk2(bf_lo(g.y) * fast_sigmoid(v0[2]), bf_hi(g.y) * fast_sigmoid(v0[3]));
                    w.z = pk2(bf_lo(g.z) * fast_sigmoid(v1[0]), bf_hi(g.z) * fast_sigmoid(v1[1])); w.w = pk2(bf_lo(g.w) * fast_sigmoid(v1[2]), bf_hi(g.w) * fast_sigmoid(v1[3]));
                    *(u32x4*)(O + off + bj * 128) = w; } }
    }
};
template <int SECOND> struct EpiProj {
    static constexpr bool PERM = true, AFTER_DRAIN = false;
    const bf16_t* gate; float* MA; bf16_t* MG;
    __device__ __forceinline__ void operator()(const f32x4 (&acc)[2][2][4][2], const Unit& u, int wr, int wc, int fr, int fq) const {
        const int row0 = u.pm * 256 + wr * 64 + fr, col0 = u.pn * 256 + wc * 32 + 8 * fq;
#pragma unroll
        for (int ai = 0; ai < 2; ++ai)
#pragma unroll
            for (int m = 0; m < 4; ++m) { const size_t off = (size_t)(row0 + ai * 128 + m * 16) * 2048 + col0;
#pragma unroll
                for (int bj = 0; bj < 2; ++bj) { f32x4 v0 = acc[ai][bj][m][0], v1 = acc[ai][bj][m][1]; const u32x4 g = *(const u32x4*)(gate + off + bj * 128);
                    v0[0] *= bf_lo(g.x); v0[1] *= bf_hi(g.x); v0[2] *= bf_lo(g.y); v0[3] *= bf_hi(g.y); v1[0] *= bf_lo(g.z); v1[1] *= bf_hi(g.z); v1[2] *= bf_lo(g.w); v1[3] *= bf_hi(g.w);
                    if (!SECOND) { *(f32x4*)(MA + off + bj * 128) = v0; *(f32x4*)(MA + off + bj * 128 + 4) = v1; }
                    else { v0 += *(const f32x4*)(MA + off + bj * 128); v1 += *(const f32x4*)(MA + off + bj * 128 + 4);
                        u32x4 w; w.x = pk2(v0[0], v0[1]); w.y = pk2(v0[2], v0[3]); w.z = pk2(v1[0], v1[1]); w.w = pk2(v1[2], v1[3]); *(u32x4*)(MG + off + bj * 128) = w; } } }
    }
};
struct EpiRes {
    static constexpr bool PERM = false, AFTER_DRAIN = false;
    const float* R; float* O;
    __device__ __forceinline__ void operator()(const f32x4 (&acc)[2][2][4][2], const Unit& u, int wr, int wc, int fr, int fq) const {
        const int row0 = u.pm * 256 + wr * 64 + fr, col0 = u.pn * 256 + wc * 32 + 4 * fq;
#pragma unroll
        for (int ai = 0; ai < 2; ++ai)
#pragma unroll
            for (int m = 0; m < 4; ++m) { const size_t off = (size_t)(row0 + ai * 128 + m * 16) * 2048 + col0;
#pragma unroll
                for (int bj = 0; bj < 2; ++bj)
#pragma unroll
                    for (int n = 0; n < 2; ++n) { const f32x4 r = *(const f32x4*)(R + off + bj * 128 + n * 16); *(f32x4*)(O + off + bj * 128 + n * 16) = r * ALPHA + acc[ai][bj][m][n]; } }
    }
};
#define DPPF(oldv, src, ctrl) __builtin_bit_cast(float, __builtin_amdgcn_update_dpp(__builtin_bit_cast(int, (float)(oldv)), __builtin_bit_cast(int, (float)(src)), (ctrl), 0xf, 0xf, false))
struct EpiUp {
    static constexpr bool PERM = true, AFTER_DRAIN = false;
    const float *cw, *cb; bf16_t* ACT; float *UPF, *UPL;
    __device__ __forceinline__ void operator()(const f32x4 (&acc)[2][2][4][2], const Unit& u, int wr, int wc, int fr, int fq) const {
        const int ch0 = u.pn * 128 + wc * 32 + 8 * fq;
#pragma unroll
        for (int ai = 0; ai < 2; ++ai) {
            const int bnd = u.pm * 4 + ai * 2 + wr; const int rowb = bnd * 64;
#pragma unroll
            for (int bj = 0; bj < 2; ++bj)
#pragma unroll
                for (int n = 0; n < 2; ++n) { const int oc = bj * DFF + ch0 + 4 * n;
                    if (fr < 2) *(f32x4*)(UPF + (size_t)(bnd * 2 + fr) * DFF2 + oc) = acc[ai][bj][0][n];
                    if (fr >= 14) *(f32x4*)(UPL + (size_t)(bnd * 2 + (fr - 14)) * DFF2 + oc) = acc[ai][bj][3][n]; }
#pragma unroll
            for (int n = 0; n < 2; ++n) {
                asm volatile("" ::: "memory");
                f32x4 res[2][4];
#pragma unroll
                for (int bj = 0; bj < 2; ++bj) { const int oc = bj * DFF + ch0 + 4 * n;
                    const f32x4 w0 = *(const f32x4*)(cw + oc), w1 = *(const f32x4*)(cw + DFF2 + oc), w2 = *(const f32x4*)(cw + 2 * DFF2 + oc), bb = *(const f32x4*)(cb + oc);
#pragma unroll
                    for (int m = 0; m < 4; ++m) { const f32x4 cur = acc[ai][bj][m][n], prv = acc[ai][bj][m == 0 ? 0 : m - 1][n]; f32x4 p1, p2;
#pragma unroll
                        for (int k = 0; k < 4; ++k) { const float r1 = DPPF(0.f, prv[k], 0x121), r2 = DPPF(0.f, prv[k], 0x122); p1[k] = DPPF(r1, cur[k], 0x111); p2[k] = DPPF(r2, cur[k], 0x112); }
                        res[bj][m] = bb + w0 * p2 + w1 * p1 + w2 * cur; }
                    asm volatile("" : "+v"(res[bj][0]), "+v"(res[bj][1]), "+v"(res[bj][2]), "+v"(res[bj][3])); }
#pragma unroll
                for (int m = 0; m < 4; ++m) { f32x4 a;
#pragma unroll
                    for (int k = 0; k < 4; ++k) { const float g = res[0][m][k]; a[k] = g * fast_sigmoid(g) * res[1][m][k]; }
                    u32x2 o; o.x = pk2(a[0], a[1]); o.y = pk2(a[2], a[3]);
                    if (!(m == 0 && fr < 2)) *(u32x2*)(ACT + (size_t)(rowb + m * 16 + fr) * DFF + ch0 + 4 * n) = o; }
            }
        }
    }
};

template <class Epi> __device__ __forceinline__ void skinny_gemm(Frame& F, const bf16_t* A16, const bf16_t* Bt, int N, int K, const Epi& E) {
    LAS float* red = (LAS float*)F.lds;
    const int nks = K / 32, l15 = F.lane & 15, kq = F.lane >> 4;
    for (int it = F.bid; it < N / 16; it += F.G) {
        f32x4 acc = {0.f, 0.f, 0.f, 0.f};
        const bf16_t* ap = A16 + (size_t)l15 * K + 8 * kq; const bf16_t* bp = Bt + (size_t)(it * 16 + l15) * K + 8 * kq;
#pragma unroll 4
        for (int ks = F.wave; ks < nks; ks += 8) { const bf16x8 a = *(const bf16x8*)(ap + ks * 32), b = *(const bf16x8*)(bp + ks * 32); acc = __builtin_amdgcn_mfma_f32_16x16x32_bf16(a, b, acc, 0, 0, 0); }
        if (F.lane < 32) {
#pragma unroll
            for (int i = 0; i < 4; ++i) red[(F.wave * 8 + kq * 4 + i) * 16 + l15] = acc[i]; }
        wg_bar();
        if (F.tid < 128) { const int row = F.tid >> 4, col = F.tid & 15; float s = 0.f;
#pragma unroll
            for (int w = 0; w < 8; ++w) s += red[(w * 8 + row) * 16 + col];
            E(row, it * 16 + col, s); }
        wg_bar();
    }
}

__device__ __forceinline__ void p0_transpose_item(const float* W, int K, int N, bf16_t* WT, int drow0, int k0, int n0, LAS float* scr, int lane) {
    const int q = lane & 15, r4 = lane >> 4;
    f32x4 v[16];
#pragma unroll
    for (int i = 0; i < 16; ++i) v[i] = __builtin_nontemporal_load((const f32x4*)(W + (size_t)(k0 + 4 * i + r4) * N + n0 + 4 * q));
#pragma unroll
    for (int i = 0; i < 16; ++i) { LAS float* d = scr + (4 * i + r4) * 65 + 4 * q; d[0] = v[i][0]; d[1] = v[i][1]; d[2] = v[i][2]; d[3] = v[i][3]; }
    asm volatile("s_waitcnt lgkmcnt(0)" ::: "memory");
    const int c = lane & 7;
#pragma unroll
    for (int j = 0; j < 8; ++j) { const int n = (lane >> 3) + 8 * j; const LAS float* s = scr + (8 * c) * 65 + n;
        u32x4 o; o.x = pk2(s[0 * 65], s[1 * 65]); o.y = pk2(s[2 * 65], s[3 * 65]); o.z = pk2(s[4 * 65], s[5 * 65]); o.w = pk2(s[6 * 65], s[7 * 65]);
        *(u32x4*)(WT + (size_t)(drow0 + n) * K + k0 + 8 * c) = o; }
    asm volatile("s_waitcnt lgkmcnt(0)" ::: "memory");
}
__device__ __forceinline__ int up_perm_row(int c) { return c < DFF ? 256 * (c >> 7) + (c & 127) : 256 * ((c - DFF) >> 7) + 128 + ((c - DFF) & 127); }
__device__ __forceinline__ int up_orig_col(int r) { const int t = r >> 8, j = r & 255; return j < 128 ? 128 * t + j : DFF + 128 * t + (j - 128); }

__device__ __forceinline__ void s5_tables_item(Frame& F, int g, int qtr, const float* a_re, const float* a_im, const float* log_dt, const float* b_re, const float* b_im, const float* c_re, const float* c_im,
                                               const float* dvec, bf16_t* Kt, bf16_t* Bpow, bf16_t* Cpow, float* sm) {
    LAS float* bbl = (LAS float*)F.lds; LAS float* cl = bbl + 2048; LAS float* pw = cl + 2048;
    if (F.tid < 64) { const int p = F.tid;
        const double dt = exp((double)log_dt[g]), ar = a_re[g * 64 + p], ai = a_im[g * 64 + p], mag = exp(ar * dt), ang = ai * dt, abr = mag * cos(ang), abi = mag * sin(ang);
        const double den = ar * ar + ai * ai, fr = ((abr - 1.0) * ar + abi * ai) / den, fi = (abi * ar - (abr - 1.0) * ai) / den;
        for (int ch = 0; ch < 16; ++ch) { const double br = b_re[(g * 64 + p) * 16 + ch], bi = b_im[(g * 64 + p) * 16 + ch]; const float xr = (float)(fr * br - fi * bi), xi = (float)(fr * bi + fi * br);
            bbl[(p * 16 + ch) * 2] = xr; bbl[(p * 16 + ch) * 2 + 1] = xi; if (qtr == 0) { sm[SM_BB + ((g * 64 + p) * 16 + ch) * 2] = xr; sm[SM_BB + ((g * 64 + p) * 16 + ch) * 2 + 1] = xi; } }
        for (int c = 0; c < 16; ++c) { cl[(c * 64 + p) * 2] = c_re[(g * 16 + c) * 64 + p]; cl[(c * 64 + p) * 2 + 1] = c_im[(g * 16 + c) * 64 + p]; }
        double pr = 1.0, pi = 0.0;
        for (int l = 0; l <= 64; ++l) { pw[(p * 66 + l) * 2] = (float)pr; pw[(p * 66 + l) * 2 + 1] = (float)pi; const double nr = pr * abr - pi * abi, ni = pr * abi + pi * abr; pr = nr; pi = ni; }
        if (qtr == 0) { sm[SM_ABAR + (g * 64 + p) * 2] = (float)abr; sm[SM_ABAR + (g * 64 + p) * 2 + 1] = (float)abi; sm[SM_ABART + (g * 64 + p) * 2] = pw[(p * 66 + 64) * 2]; sm[SM_ABART + (g * 64 + p) * 2 + 1] = pw[(p * 66 + 64) * 2 + 1]; }
    }
    wg_bar();
    for (int k = 0; k < 8; ++k) { const int idx = F.tid + 512 * k, l = 16 * qtr + (idx >> 8), c = (idx >> 4) & 15, ch = idx & 15; float s = 0.f;
        for (int p = 0; p < 64; ++p) { const float cr = cl[(c * 64 + p) * 2], ci = cl[(c * 64 + p) * 2 + 1], pr = pw[(p * 66 + l) * 2], pi = pw[(p * 66 + l) * 2 + 1];
            const float er = cr * pr - ci * pi, ei = cr * pi + ci * pr; s += er * bbl[(p * 16 + ch) * 2] - ei * bbl[(p * 16 + ch) * 2 + 1]; }
        if (l == 0 && c == ch) s += dvec[16 * g + c];
        Kt[((size_t)(g * 64 + l) * 16 + c) * 16 + ch] = f2bf(s); }
    for (int k = 0; k < 64; ++k) { const int idx = F.tid + 512 * k, p = 16 * qtr + (idx >> 11), part = (idx >> 10) & 1, jc = idx & 1023, j = jc >> 4, ch = jc & 15;
        const float pr = pw[(p * 66 + 63 - j) * 2], pi = pw[(p * 66 + 63 - j) * 2 + 1], br = bbl[(p * 16 + ch) * 2], bi = bbl[(p * 16 + ch) * 2 + 1];
        Bpow[((size_t)g * 128 + part * 64 + p) * 1024 + jc] = f2bf(part ? pr * bi + pi * br : pr * br - pi * bi); }
    for (int k = 0; k < 64; ++k) { const int idx = F.tid + 512 * k, i = 16 * qtr + (idx >> 11), c = (idx >> 7) & 15, kk = idx & 127, p = kk & 63;
        const float cr = cl[(c * 64 + p) * 2], ci = cl[(c * 64 + p) * 2 + 1], pr = pw[(p * 66 + i + 1) * 2], pi = pw[(p * 66 + i + 1) * 2 + 1];
        Cpow[((size_t)g * 1024 + i * 16 + c) * 128 + kk] = f2bf(kk < 64 ? cr * pr - ci * pi : -(cr * pi + ci * pr)); }
    wg_bar();
}

#define MFMA32(a, b, c) __builtin_amdgcn_mfma_f32_32x32x16_bf16((a), (b), (c), 0, 0, 0)
__device__ __forceinline__ int crow(int r, int hi) { return (r & 3) + 8 * (r >> 2) + 4 * hi; }
__device__ __forceinline__ void s5_unit(Frame& F, int b, int g, const bf16_t* Ub, const bf16_t* Kt, const bf16_t* Bpow, const bf16_t* Cpow, const float* sm, bf16_t* Gb, float* out_re, float* out_im) {
    LAS bf16_t* Ul = (LAS bf16_t*)F.lds;
    LAS bf16_t* Kl = (LAS bf16_t*)(F.lds + 65536);
    LAS float* Gs = (LAS float*)(F.lds + 98304);
    LAS bf16_t* Hl = (LAS bf16_t*)(F.lds + 114688);
    const int r32 = F.lane & 31, hi = F.lane >> 5, w = F.wave;
#pragma unroll
    for (int i = 0; i < 8; ++i) { const int idx = F.tid + 512 * i, ts = idx >> 1, hf = idx & 1, col = ts >> 6, j = ts & 63;
        const u32x4 v = *(const u32x4*)(Ub + (size_t)(b * SEQ + ts) * 1024 + 16 * g + 8 * hf); *(LAS u32x4*)(Ul + ((j * 32 + col) * 16 + 8 * hf)) = v; }
#pragma unroll
    for (int i = 0; i < 4; ++i) { const int idx = F.tid + 512 * i; *(LAS u32x4*)(Kl + idx * 8) = *(const u32x4*)(Kt + (size_t)g * 16384 + idx * 8); }
    wg_bar();
    { const int mt = w & 3, kh = w >> 2; f32x16 acc = {};
      const bf16_t* ap = Bpow + ((size_t)g * 128 + 32 * mt + r32) * 1024 + 8 * hi;
#pragma unroll 4
      for (int js = 0; js < 32; ++js) { const int j = kh * 32 + js; const bf16x8 a = *(const bf16x8*)(ap + j * 16); const bf16x8 bf = *(const LAS bf16x8*)(Ul + ((j * 32 + r32) * 16 + 8 * hi)); acc = MFMA32(a, bf, acc); }
      if (kh == 0) {
#pragma unroll
          for (int i = 0; i < 16; ++i) Gs[(32 * mt + crow(i, hi)) * 32 + r32] = acc[i]; }
      wg_bar();
      if (kh == 1) {
#pragma unroll
          for (int i = 0; i < 16; ++i) Gs[(32 * mt + crow(i, hi)) * 32 + r32] += acc[i]; }
      wg_bar(); }
    if (w == 0) { const int p = F.lane; const float ar = sm[SM_ABART + (g * 64 + p) * 2], ai = sm[SM_ABART + (g * 64 + p) * 2 + 1]; float hr = 0.f, hi_ = 0.f;
        for (int col = 0; col < 32; ++col) { Hl[col * 128 + p] = f2bf(hr); Hl[col * 128 + 64 + p] = f2bf(hi_);
            const float gr = Gs[p * 32 + col], gi = Gs[(64 + p) * 32 + col]; const float nr = ar * hr - ai * hi_ + gr, ni = ar * hi_ + ai * hr + gi; hr = nr; hi_ = ni; }
        out_re[(b * NG + g) * 64 + p] = hr; out_im[(b * NG + g) * 64 + p] = hi_; }
    wg_bar();
#pragma unroll 1
    for (int q = 0; q < 4; ++q) { const int mt = (q == 0) ? w : (q == 1) ? 15 - w : (q == 2) ? 16 + w : 31 - w; f32x16 acc = {};
        const int il = r32 >> 4, c = r32 & 15; const int nj = 2 * mt + 2;
#pragma unroll 2
        for (int j = 0; j < nj; ++j) { const int lag = 2 * mt + il - j; bf16x8 a = {0, 0, 0, 0, 0, 0, 0, 0};
            if (lag >= 0) a = *(const LAS bf16x8*)(Kl + ((lag * 16 + c) * 16 + 8 * hi));
            const bf16x8 bf = *(const LAS bf16x8*)(Ul + ((j * 32 + r32) * 16 + 8 * hi)); acc = MFMA32(a, bf, acc); }
        const bf16_t* cp = Cpow + ((size_t)g * 1024 + 32 * mt + r32) * 128 + 8 * hi;
#pragma unroll
        for (int ks = 0; ks < 8; ++ks) { const bf16x8 a = *(const bf16x8*)(cp + ks * 16); const bf16x8 bf = *(const LAS bf16x8*)(Hl + (r32 * 128 + ks * 16 + 8 * hi)); acc = MFMA32(a, bf, acc); }
#pragma unroll
        for (int grp = 0; grp < 4; ++grp) { const int i = 2 * mt + (grp >> 1), c0 = 8 * (grp & 1) + 4 * hi; const size_t tok = (size_t)b * SEQ + 64 * r32 + i;
            u32x2 o; o.x = pk2(gelu_tanh_f(acc[4 * grp]), gelu_tanh_f(acc[4 * grp + 1])); o.y = pk2(gelu_tanh_f(acc[4 * grp + 2]), gelu_tanh_f(acc[4 * grp + 3]));
            *(u32x2*)(Gb + tok * 1024 + 16 * g + c0) = o; } }
    wg_bar();
}

__device__ __forceinline__ void s5_sample_item(Frame& F, int bs, int g, float* sm, const float* st_re, const float* st_im, const float* c_re, const float* c_im, const float* dvec, float* o_re, float* o_im, bf16_t* Gb) {
    const int p = F.lane; const float* zs = sm + SM_ZS + bs * INW + 3072 + 16 * g;
    const float abr = sm[SM_ABAR + (g * 64 + p) * 2], abi = sm[SM_ABAR + (g * 64 + p) * 2 + 1]; const float x0r = st_re[(bs * NG + g) * 64 + p], x0i = st_im[(bs * NG + g) * 64 + p];
    float br = 0.f, bi = 0.f;
#pragma unroll
    for (int ch = 0; ch < 16; ++ch) { const float u = zs[ch]; br += sm[SM_BB + ((g * 64 + p) * 16 + ch) * 2] * u; bi += sm[SM_BB + ((g * 64 + p) * 16 + ch) * 2 + 1] * u; }
    const float xr = abr * x0r - abi * x0i + br, xi = abr * x0i + abi * x0r + bi;
    o_re[(bs * NG + g) * 64 + p] = xr; o_im[(bs * NG + g) * 64 + p] = xi;
    float myy = 0.f;
#pragma unroll
    for (int c = 0; c < 16; ++c) { float y = wave_sum(xr * c_re[(g * 16 + c) * 64 + p] - xi * c_im[(g * 16 + c) * 64 + p]); if (p == c) myy = y; }
    if (p < 16) { const float y = myy + dvec[16 * g + p] * zs[p]; const float gl = gelu_tanh_f(y); sm[SM_GS + bs * 1024 + 16 * g + p] = gl; Gb[(size_t)(MP + bs) * 1024 + 16 * g + p] = f2bf(gl); }
}

#define DPP_ADD(v, ctrl) ((v) + DPPF((v), (v), (ctrl)))
__device__ __forceinline__ float row16_sum(float v) { v = DPP_ADD(v, 0xB1); v = DPP_ADD(v, 0x4E); v = DPP_ADD(v, 0x141); v = DPP_ADD(v, 0x140); return v; }
__device__ __forceinline__ void decode_unit(Frame& F, int bs, int quad, const float* sm, const float* ck, const float* cv, const int* pt, float* dpart) {
    const int lane = F.lane, w = F.wave;
    f32x4 qv[4];
#pragma unroll
    for (int i = 0; i < 4; ++i) qv[i] = *(const f32x4*)(sm + SM_ZS + bs * INW + 4 * (64 * i + lane)) * C2;
    float m[4], l[4]; f32x4 o[4][2];
#pragma unroll
    for (int i = 0; i < 4; ++i) { m[i] = -1e30f; l[i] = 0.f; o[i][0] = (f32x4){0.f, 0.f, 0.f, 0.f}; o[i][1] = (f32x4){0.f, 0.f, 0.f, 0.f}; }
    const int jown = (lane >> 4) & 1;
#pragma unroll 1
    for (int pg = 0; pg < 4; ++pg) { const int pidx = quad * 4 + pg; const int page = pt[bs * NPAGES + pidx];
#pragma unroll 1
        for (int sb = 0; sb < 4; ++sb) {
            f32x4 kv[4][4], vv[4][4];
#pragma unroll
            for (int t = 0; t < 4; ++t) { const size_t tokoff = ((size_t)page * PAGE + w + 8 * (4 * sb + t)) * 1024;
#pragma unroll
                for (int i = 0; i < 4; ++i) { kv[t][i] = __builtin_nontemporal_load((const f32x4*)(ck + tokoff + 4 * (64 * i + lane))); vv[t][i] = __builtin_nontemporal_load((const f32x4*)(cv + tokoff + 4 * (64 * i + lane))); } }
            float s[4][4];
#pragma unroll
            for (int t = 0; t < 4; ++t)
#pragma unroll
                for (int i = 0; i < 4; ++i) { const f32x4 pr = kv[t][i] * qv[i]; s[t][i] = row16_sum((pr[0] + pr[1]) + (pr[2] + pr[3])); }
            if (pidx == NPAGES - 1) {
#pragma unroll
                for (int t = 0; t < 4; ++t) { const int n = PAST - (pidx * PAGE + w + 8 * (4 * sb + t));
                    if (n < 128) {
#pragma unroll
                        for (int i = 0; i < 4; ++i) s[t][i] += sm[SM_TB + ((4 * i + (lane >> 4)) >> 1) * 128 + n]; } } }
            float sc[4], pown[4][4];
#pragma unroll
            for (int i = 0; i < 4; ++i) { const float mx = fmaxf(fmaxf(s[0][i], s[1][i]), fmaxf(s[2][i], s[3][i])); const float mn = fmaxf(m[i], mx); sc[i] = __builtin_amdgcn_exp2f(m[i] - mn); m[i] = mn; float ls = 0.f;
#pragma unroll
                for (int t = 0; t < 4; ++t) { pown[t][i] = __builtin_amdgcn_exp2f(s[t][i] - mn); ls += pown[t][i]; }
                l[i] = l[i] * sc[i] + ls; }
#pragma unroll
            for (int i = 0; i < 4; ++i) { const float so = __shfl_xor(sc[i], 16); const float s0 = jown ? so : sc[i], s1 = jown ? sc[i] : so; o[i][0] = o[i][0] * s0; o[i][1] = o[i][1] * s1;
#pragma unroll
                for (int t = 0; t < 4; ++t) { const float po = __shfl_xor(pown[t][i], 16); const float p0 = jown ? po : pown[t][i], p1 = jown ? pown[t][i] : po; o[i][0] += vv[t][i] * p0; o[i][1] += vv[t][i] * p1; } }
        } }
    LAS float* Ol = (LAS float*)F.lds; LAS float* ml = Ol + 8 * 16 * 128;
#pragma unroll
    for (int i = 0; i < 4; ++i) { const int hj0 = 4 * i + 2 * (lane >> 5);
        *(LAS f32x4*)(Ol + ((w * 16 + hj0) * 128 + 4 * (lane & 31))) = o[i][0]; *(LAS f32x4*)(Ol + ((w * 16 + hj0 + 1) * 128 + 4 * (lane & 31))) = o[i][1];
        if ((lane & 15) == 0) { ml[(w * 16 + 4 * i + (lane >> 4)) * 2] = m[i]; ml[(w * 16 + 4 * i + (lane >> 4)) * 2 + 1] = l[i]; } }
    wg_bar();
    { const int hj = F.tid >> 5, e4 = F.tid & 31; float M = -1e30f;
#pragma unroll
      for (int ww = 0; ww < 8; ++ww) M = fmaxf(M, ml[(ww * 16 + hj) * 2]);
      float L = 0.f; f32x4 O = {0.f, 0.f, 0.f, 0.f};
#pragma unroll
      for (int ww = 0; ww < 8; ++ww) { const float f = __builtin_amdgcn_exp2f(ml[(ww * 16 + hj) * 2] - M); L += ml[(ww * 16 + hj) * 2 + 1] * f; O += *(const LAS f32x4*)(Ol + ((ww * 16 + hj) * 128 + 4 * e4)) * f; }
      float* dp = dpart + ((size_t)(bs * 32 + quad) * 16 + hj) * 132; *(f32x4*)(dp + 4 * e4) = O; if (e4 == 0) { dp[128] = M; dp[129] = L; } }
    wg_bar();
}
__device__ __forceinline__ void decode_combine_item(Frame& F, int bs, int h, const float* sm, const float* dpart, const float* subg, bf16_t* ATT) {
    const int lane = F.lane; const float lam = sm[SM_LAM]; f32x2 res[2];
#pragma unroll
    for (int j = 0; j < 2; ++j) { const int hj = 2 * h + j;
        float sd = 0.f; { const float* zq = sm + SM_ZS + bs * INW + hj * 64; const float* zk = sm + SM_ZS + bs * INW + 1024 + hj * 64; sd = wave_sum(zq[lane] * zk[lane]) * C2 + sm[SM_TB + h * 128 + 0]; }
        float M = sd;
        for (int sp = 0; sp < 32; ++sp) M = fmaxf(M, dpart[((size_t)(bs * 32 + sp) * 16 + hj) * 132 + 128]);
        const float fs = __builtin_amdgcn_exp2f(sd - M); float L = fs; f32x2 O = *(const f32x2*)(sm + SM_ZS + bs * INW + 2048 + h * 128 + 2 * lane) * fs;
        for (int sp = 0; sp < 32; ++sp) { const float* dp = dpart + ((size_t)(bs * 32 + sp) * 16 + hj) * 132; const float f = __builtin_amdgcn_exp2f(dp[128] - M); L += dp[129] * f; O += *(const f32x2*)(dp + 2 * lane) * f; }
        res[j] = O * (1.f / L); }
    const f32x2 d = res[0] - res[1] * lam; const float ss = wave_sum(d[0] * d[0] + d[1] * d[1]); const float r = rsqrtf(ss * (1.f / 128.f) + LN_EPS) * 0.8f;
    *(unsigned*)(ATT + (size_t)(MP + bs) * 1024 + h * 128 + 2 * lane) = pk2(d[0] * r * subg[2 * lane], d[1] * r * subg[2 * lane + 1]);
}
__device__ __forceinline__ void attn_combine_row(Frame& F, int row, const float lam, const bf16_t* O0, const bf16_t* O1, const float* subg, bf16_t* ATT) {
    const int lane = F.lane; const size_t off = (size_t)row * 1024 + lane * 16; float d[16];
#pragma unroll
    for (int q = 0; q < 2; ++q) { const u32x4 a = *(const u32x4*)(O0 + off + 8 * q), b = *(const u32x4*)(O1 + off + 8 * q);
        d[8 * q + 0] = bf_lo(a.x) - lam * bf_lo(b.x); d[8 * q + 1] = bf_hi(a.x) - lam * bf_hi(b.x); d[8 * q + 2] = bf_lo(a.y) - lam * bf_lo(b.y); d[8 * q + 3] = bf_hi(a.y) - lam * bf_hi(b.y);
        d[8 * q + 4] = bf_lo(a.z) - lam * bf_lo(b.z); d[8 * q + 5] = bf_hi(a.z) - lam * bf_hi(b.z); d[8 * q + 6] = bf_lo(a.w) - lam * bf_lo(b.w); d[8 * q + 7] = bf_hi(a.w) - lam * bf_hi(b.w); }
    float ss = 0.f;
#pragma unroll
    for (int k = 0; k < 16; ++k) ss += d[k] * d[k];
    ss += __shfl_xor(ss, 1); ss += __shfl_xor(ss, 2); ss += __shfl_xor(ss, 4);
    const float r = rsqrtf(ss * (1.f / 128.f) + LN_EPS) * 0.8f; const int e0 = (lane & 7) * 16;
#pragma unroll
    for (int q = 0; q < 2; ++q) { u32x4 o; o.x = pk2(d[8 * q] * r * subg[e0 + 8 * q], d[8 * q + 1] * r * subg[e0 + 8 * q + 1]); o.y = pk2(d[8 * q + 2] * r * subg[e0 + 8 * q + 2], d[8 * q + 3] * r * subg[e0 + 8 * q + 3]);
        o.z = pk2(d[8 * q + 4] * r * subg[e0 + 8 * q + 4], d[8 * q + 5] * r * subg[e0 + 8 * q + 5]); o.w = pk2(d[8 * q + 6] * r * subg[e0 + 8 * q + 6], d[8 * q + 7] * r * subg[e0 + 8 * q + 7]);
        *(u32x4*)(ATT + off + 8 * q) = o; }
}
__device__ __forceinline__ void ln_row(Frame& F, const float* x, const float* g, const float* b, float* of, bf16_t* ob) {
    const int lane = F.lane; f32x4 v[8]; float s = 0.f;
#pragma unroll
    for (int j = 0; j < 8; ++j) { v[j] = *(const f32x4*)(x + 4 * (lane + 64 * j)); s += (v[j][0] + v[j][1]) + (v[j][2] + v[j][3]); }
    const float mu = wave_sum(s) * (1.f / DM); float q = 0.f;
#pragma unroll
    for (int j = 0; j < 8; ++j) { v[j] = v[j] - mu; q += (v[j][0] * v[j][0] + v[j][1] * v[j][1]) + (v[j][2] * v[j][2] + v[j][3] * v[j][3]); }
    const float rstd = rsqrtf(wave_sum(q) * (1.f / DM) + LN_EPS);
#pragma unroll
    for (int j = 0; j < 8; ++j) { const int c = 4 * (lane + 64 * j); const f32x4 o = v[j] * rstd * *(const f32x4*)(g + c) + *(const f32x4*)(b + c); *(f32x4*)(of + c) = o;
        if (ob) { u32x2 w; w.x = pk2(o[0], o[1]); w.y = pk2(o[2], o[3]); *(u32x2*)(ob + c) = w; } }
}
}
#ifndef NOBIAS
#define NOBIAS 0
#endif
namespace mk {
__device__ const unsigned char BUCKET[128] = {0, 1, 2, 3, 4, 5, 6, 7, 8, 9, 10, 11, 12, 13, 14, 15, 16, 16, 16, 17, 17, 18, 18, 18, 19, 19, 19, 20, 20, 20, 20, 21, 21, 21, 21, 22, 22, 22, 22, 22, 23, 23, 23, 23, 23, 23, 24, 24, 24, 24, 24, 24, 25, 25, 25, 25, 25, 25, 25, 26, 26, 26, 26, 26, 26, 26, 26, 27, 27, 27, 27, 27, 27, 27, 27, 27, 27, 28, 28, 28, 28, 28, 28, 28, 28, 28, 28, 29, 29, 29, 29, 29, 29, 29, 29, 29, 29, 29, 29, 30, 30, 30, 30, 30, 30, 30, 30, 30, 30, 30, 30, 30, 30, 31, 31, 31, 31, 31, 31, 31, 31, 31, 31, 31, 31, 31, 31, 31};
struct SkZs { float* zs; float* oK; float* oV; __device__ __forceinline__ void operator()(int row, int col, float a) const { zs[row * INW + col] = a; if (col >= 1024 && col < 2048) oK[row * 1024 + col - 1024] = a; else if (col >= 2048 && col < 3072) oV[row * 1024 + col - 2048] = a; } };
struct SkGlu { const float* gs; bf16_t* O; __device__ __forceinline__ void operator()(int row, int col, float a) const { O[(size_t)(MP + row) * 1024 + col] = f2bf(gs[row * 1024 + col] * fast_sigmoid(a)); } };
struct SkPA { const float* zs; float* mas; __device__ __forceinline__ void operator()(int row, int col, float a) const { mas[row * DM + col] = fast_sigmoid(zs[row * INW + 4096 + col]) * a; } };
struct SkPS { const float* zs; const float* mas; bf16_t* MG; __device__ __forceinline__ void operator()(int row, int col, float a) const { MG[(size_t)(MP + row) * DM + col] = f2bf(mas[row * DM + col] + fast_sigmoid(zs[row * INW + 6144 + col]) * a); } };
struct SkRes { const float* R; float* O; __device__ __forceinline__ void operator()(int row, int col, float a) const { O[row * DM + col] = ALPHA * R[row * DM + col] + a; } };
struct SkUp { float* ups; __device__ __forceinline__ void operator()(int row, int col, float a) const { ups[row * DFF2 + up_orig_col(col)] = a; } };

__device__ __forceinline__ int lane_id_fresh() { int l; asm volatile("v_mbcnt_lo_u32_b32 %0, -1, 0\n\tv_mbcnt_hi_u32_b32 %0, -1, %0" : "=v"(l)); return l; }
#define REFRESH_F() do { F.lane = lane_id_fresh(); F.tid = F.wave * 64 + F.lane; } while (0)
typedef const char __attribute__((address_space(4)))* kargp_t;
__device__ __forceinline__ kargp_t karg() { kargp_t p = (kargp_t)__builtin_amdgcn_kernarg_segment_ptr(); asm volatile("" : "+s"(p)); return p; }
#define INP(k) (*(const float* const __attribute__((address_space(4)))*)(karg() + 8 * (k)))
__global__ void __launch_bounds__(NTHREADS, 2) mk_fwd(Args args) {
    extern __shared__ __attribute__((aligned(16))) unsigned char lds_raw[];
    Frame F; F.lds = (ldsp_t)lds_raw; F.wave = __builtin_amdgcn_readfirstlane((int)threadIdx.x) >> 6; F.lane = mk_lane(); F.tid = F.wave * 64 + F.lane; F.bid = blockIdx.x; F.G = gridDim.x;
    F.vcu = (F.G % 8 == 0) ? (F.bid % 8) * (F.G / 8) + F.bid / 8 : F.bid;
    volatile LAS unsigned* MISC = (volatile LAS unsigned*)(F.lds + MISC_OFF);
    unsigned char* ws = args.ws; unsigned* ctl = (unsigned*)(ws + WS_CTL);
    for (int u = F.tid; u < (LDS_BYTES - LDSCTL_OFF) / 4; u += NTHREADS) ((LAS unsigned*)(F.lds + LDSCTL_OFF))[u] = 0u;
    __syncthreads();
    const int lo = args.ph_lo, hi = args.ph_hi;
    XcdBarrier bar; bar.bar = ctl + CW_BAR; bar.x = 0; bar.st = nullptr;
    if (hi - lo > 1) bar = xcd_barrier_post(ctl + CW_BAR, MISC + 8);
#ifndef PHMASK
#define PHMASK 0x7ff
#endif
#define IN(k) ((((PHMASK) >> (k)) & 1) && lo <= (k) && (k) < hi)
#ifndef REP_PH
#define REP_PH -1
#endif
#ifndef REP_N
#define REP_N 2
#endif
#define NREP(k) (((k) == REP_PH) ? 1 + REP_N : 1)
#ifndef TPA
#define TPA -1
#endif
#ifndef TPB
#define TPB -1
#endif
#define STAMP(k) do { if (TPA >= 0 && F.bid == 0 && F.tid == 0) ((unsigned long long*)(ctl + 8192))[k] = __builtin_amdgcn_s_memrealtime(); } while (0)
#define SEAM(k) do { if (IN(k) && IN((k) + 1)) xcd_barrier(bar); STAMP((k) + 1); } while (0)
#define x_prompt INP(0)
#define x_sample INP(1)
#define cache_k INP(2)
#define cache_v INP(3)
#define st_re INP(4)
#define st_im INP(5)
#define st_conv INP(6)
#define page_table ((const int*)INP(7))
#define rel_bias INP(8)
#define subln_g INP(14)
#define ln1_g INP(27)
#define ln1_b INP(28)
#define conv_w INP(30)
#define conv_b INP(31)
#define ln2_g INP(33)
#define ln2_b INP(34)
#define OUTB (args.out)
#define o_yp (OUTB)
#define o_ys (OUTB + (size_t)MP * DM)
#define o_kp (o_ys + (size_t)DB * DM)
#define o_vp (o_kp + (size_t)MP * 1024)
#define o_rep (o_vp + (size_t)MP * 1024)
#define o_imp (o_rep + NB * 4096)
#define o_cp (o_imp + NB * 4096)
#define o_ks (o_cp + (size_t)NB * 2 * DFF2)
#define o_vs (o_ks + DB * 1024)
#define o_res (o_vs + DB * 1024)
#define o_ims (o_res + DB * 4096)
#define o_cs (o_ims + DB * 4096)
#define WIN ((bf16_t*)(ws + WS_WIN))
#define WGLU ((bf16_t*)(ws + WS_WGLU))
#define WPA ((bf16_t*)(ws + WS_WPA))
#define WPS ((bf16_t*)(ws + WS_WPS))
#define WOUT ((bf16_t*)(ws + WS_WOUT))
#define WUP ((bf16_t*)(ws + WS_WUP))
#define WDOWN ((bf16_t*)(ws + WS_WDOWN))
#define XB ((bf16_t*)(ws + WS_XB))
#define Qb ((bf16_t*)(ws + WS_Q))
#define Kb ((bf16_t*)(ws + WS_K))
#define Vb ((bf16_t*)(ws + WS_V))
#define Ub ((bf16_t*)(ws + WS_U))
#define GAb ((bf16_t*)(ws + WS_GA))
#define GSb ((bf16_t*)(ws + WS_GS))
#define O0b ((bf16_t*)(ws + WS_O0))
#define O1b ((bf16_t*)(ws + WS_O1))
#define ATTb ((bf16_t*)(ws + WS_ATT))
#define Gb ((bf16_t*)(ws + WS_G))
#define SSMb ((bf16_t*)(ws + WS_SSM))
#define MA ((float*)(ws + WS_MA))
#define MGb ((bf16_t*)(ws + WS_MG))
#define S1 ((float*)(ws + WS_S1))
#define Hf ((float*)(ws + WS_HF))
#define Hb ((bf16_t*)(ws + WS_HB))
#define ACTb ((bf16_t*)(ws + WS_ACT))
#define S2 ((float*)(ws + WS_S2))
#define UPF ((float*)(ws + WS_UPF))
#define UPL ((float*)(ws + WS_UPL))
#define KT ((bf16_t*)(ws + WS_KT))
#define BPOW ((bf16_t*)(ws + WS_BPOW))
#define CPOW ((bf16_t*)(ws + WS_CPOW))
#define sm ((float*)(ws + WS_SMALL))
#define dpart ((float*)(ws + WS_DPART))
    const int gw = F.vcu * NWAVES + F.wave, NGW = F.G * NWAVES;

    STAMP(0);
    if (IN(0)) for (int rep_ = 0; rep_ < NREP(0); ++rep_) { REFRESH_F();
        for (int it = F.bid; it < 256; it += F.G)
            s5_tables_item(F, it >> 2, it & 3, INP(15), INP(16), INP(17), INP(18), INP(19), INP(20),
                           INP(21), INP(22), KT, BPOW, CPOW, sm);
        if (F.bid == 0) {
            for (int idx = F.tid; idx < 1024; idx += NTHREADS) { const int h = idx >> 7, n = idx & 127; sm[SM_TB + idx] = NOBIAS ? 0.f : (rel_bias[BUCKET[n] * NH + h] - rel_bias[31 * NH + h]) * LOG2E; }
            if (F.tid == 0) { const float* q1 = INP(10); const float* k1 = INP(11); const float* q2 = INP(12); const float* k2 = INP(13);
                float a = 0.f, b = 0.f; for (int i = 0; i < 64; ++i) { a += q1[i] * k1[i]; b += q2[i] * k2[i]; } sm[SM_LAM] = expf(a) - expf(b) + 0.2f; }
        }
        LAS float* scr = (LAS float*)(F.lds + F.wave * 16640);
        constexpr int WIDX[7] = {9, 23, 24, 25, 26, 29, 32}; constexpr size_t WOFF[7] = {WS_WIN, WS_WGLU, WS_WPA, WS_WPS, WS_WOUT, WS_WUP, WS_WDOWN};
        constexpr int WK[7] = {2048, 1024, 1024, 1024, 2048, 2048, 5504}, WN[7] = {8192, 1024, 2048, 2048, 2048, 11008, 2048};
        int it = gw;
#pragma unroll
        for (int mi = 0; mi < 7; ++mi) { const int nblk = WN[mi] / 64, items = (WK[mi] / 64) * nblk;
            for (; it < items; it += NGW) { const int kb = it / nblk, nb = it % nblk, n0 = 64 * nb; p0_transpose_item(INP(WIDX[mi]), WK[mi], WN[mi], (bf16_t*)(ws + WOFF[mi]), mi == 5 ? up_perm_row(n0) : n0, 64 * kb, n0, scr, F.lane); }
            it -= items; }
        for (int m = gw; m < MT; m += NGW) { const float* xr = m < MP ? x_prompt + (size_t)m * DM : x_sample + (size_t)(m - MP) * DM; bf16_t* orow = XB + (size_t)m * DM;
#pragma unroll
            for (int j = 0; j < 8; ++j) { const f32x4 v = *(const f32x4*)(xr + 4 * (F.lane + 64 * j)); u32x2 w; w.x = pk2(v[0], v[1]); w.y = pk2(v[2], v[3]); *(u32x2*)(orow + 4 * (F.lane + 64 * j)) = w; } }
        if (NREP(0) > 1) xcd_barrier(bar);
    }
    SEAM(0);
    if (IN(1)) for (int rep_ = 0; rep_ < NREP(1); ++rep_) { REFRESH_F();
        pg8::Gemm g{XB, WIN, MP, INW, DM}; pg8::StaticOrder S; S.init(MP, INW, F.G, F.bid);
        EpiIn E{Qb, Kb, Vb, Ub, GAb, GSb, o_kp, o_vp};
        pg8::gemm_phase<EpiIn, pg8::StaticOrder, true, true>(F.lds, g, S, E);
        SkZs e{sm + SM_ZS, o_ks, o_vs}; skinny_gemm(F, XB + (size_t)MP * DM, WIN, INW, DM, e);
        if (NREP(1) > 1) xcd_barrier(bar);
    }
    SEAM(1);
    if (IN(2)) for (int rep_ = 0; rep_ < NREP(2); ++rep_) { REFRESH_F();
#ifndef P2MASK
#define P2MASK 15
#endif
        if ((P2MASK & 4) && (F.bid & 1)) for (int r2_ = 0; r2_ < NREP(20); ++r2_) { for (int u = F.vcu; u < DB * 32; u += F.G) decode_unit(F, u >> 5, u & 31, sm, cache_k, cache_v, page_table, dpart); REFRESH_F(); }
        if (P2MASK & 1) { const int h0 = (((2 * F.vcu) >> 3) & 15) >> 1; LAS float* tbx = (LAS float*)(F.lds + attn_body::LDS_TBX);
            for (int i = F.tid; i < 640; i += NTHREADS) { const int n = i - 256; tbx[i] = (n >= 0 && n < 128) ? sm[SM_TB + h0 * 128 + n] : 0.f; }
            wg_bar(); }
        if (P2MASK & 1) for (int r2_ = 0; r2_ < NREP(21); ++r2_) for (int k = 0; k < 2; ++k) { const int pid = 2 * F.vcu + k; if (pid >= 512) break;
            const int s = pid & 3, grp = pid >> 2, vh = grp & 1, hj = (grp >> 1) & 15, b = grp >> 5, h = hj >> 1;
            attn_body::bf16* Oj = (attn_body::bf16*)((hj & 1) ? O1b : O0b);
            attn_body::attn_unit<8>(b, hj * 64, (2 * h + vh) * 64, s, (const attn_body::bf16*)Qb, (const attn_body::bf16*)Kb, (const attn_body::bf16*)Vb, Oj, (char*)lds_raw);
            attn_body::attn_unit<8>(b, hj * 64, (2 * h + vh) * 64, 7 - s, (const attn_body::bf16*)Qb, (const attn_body::bf16*)Kb, (const attn_body::bf16*)Vb, Oj, (char*)lds_raw); }
        REFRESH_F(); wg_bar();
        if (P2MASK & 2) for (int r2_ = 0; r2_ < NREP(22); ++r2_) for (int u = F.vcu; u < NB * NG; u += F.G) s5_unit(F, u >> 6, u & 63, Ub, KT, BPOW, CPOW, sm, Gb, o_rep, o_imp);
        if ((P2MASK & 4) && !(F.bid & 1)) for (int r2_ = 0; r2_ < NREP(20); ++r2_) for (int u = F.vcu; u < DB * 32; u += F.G) decode_unit(F, u >> 5, u & 31, sm, cache_k, cache_v, page_table, dpart);
        if (P2MASK & 8) for (int it = gw; it < DB * NG; it += NGW) s5_sample_item(F, it >> 6, it & 63, sm, st_re, st_im, INP(20), INP(21), INP(22), o_res, o_ims, Gb);
        if (NREP(2) > 1) xcd_barrier(bar);
    }
    SEAM(2);
    if (IN(3)) for (int rep_ = 0; rep_ < NREP(3); ++rep_) { REFRESH_F();
        const int half = F.G / 2;
        if (F.bid < half) {
            pg8::Gemm g{Gb, WGLU, MP, 1024, 1024}; pg8::StaticOrder S; S.init(MP, 1024, F.G, F.bid); EpiGlu E{Gb, SSMb};
            pg8::gemm_phase<EpiGlu, pg8::StaticOrder, true, true>(F.lds, g, S, E);
        } else {
            const float lam = sm[SM_LAM]; const int tw = (F.bid - half) * NWAVES + F.wave, ntw = (F.G - half) * NWAVES;
            for (int row = tw; row < MP; row += ntw) attn_combine_row(F, row, lam, O0b, O1b, subln_g, ATTb);
            for (int it = tw; it < DB * NH; it += ntw) decode_combine_item(F, it >> 3, it & 7, sm, dpart, subln_g, ATTb);
        }
        wg_bar();
        SkGlu e{sm + SM_GS, SSMb}; skinny_gemm(F, Gb + (size_t)MP * 1024, WGLU, 1024, 1024, e);
        if (NREP(3) > 1) xcd_barrier(bar);
    }
    SEAM(3);
    if (IN(4)) for (int rep_ = 0; rep_ < NREP(4); ++rep_) { REFRESH_F();
        { pg8::Gemm g{ATTb, WPA, MP, DM, 1024}; pg8::StaticOrder S; S.init(MP, DM, F.G, F.bid); EpiProj<0> E{GAb, MA, MGb};
          pg8::gemm_phase<EpiProj<0>, pg8::StaticOrder, true, true>(F.lds, g, S, E);
          SkPA e{sm + SM_ZS, sm + SM_MAS}; skinny_gemm(F, ATTb + (size_t)MP * 1024, WPA, DM, 1024, e); }
        { pg8::Gemm g{SSMb, WPS, MP, DM, 1024}; pg8::StaticOrder S; S.init(MP, DM, F.G, F.bid); EpiProj<1> E{GSb, MA, MGb};
          pg8::gemm_phase<EpiProj<1>, pg8::StaticOrder, true, true>(F.lds, g, S, E);
          SkPS e{sm + SM_ZS, sm + SM_MAS, MGb}; skinny_gemm(F, SSMb + (size_t)MP * 1024, WPS, DM, 1024, e); }
        if (NREP(4) > 1) xcd_barrier(bar);
    }
    SEAM(4);
    if (IN(5)) for (int rep_ = 0; rep_ < NREP(5); ++rep_) { REFRESH_F();
        pg8::Gemm g{MGb, WOUT, MP, DM, DM}; pg8::StaticOrder S; S.init(MP, DM, F.G, F.bid); EpiRes E{x_prompt, S1};
        pg8::gemm_phase<EpiRes, pg8::StaticOrder, true, true>(F.lds, g, S, E);
        SkRes e{x_sample, sm + SM_S1S}; skinny_gemm(F, MGb + (size_t)MP * DM, WOUT, DM, DM, e);
        if (NREP(5) > 1) xcd_barrier(bar);
    }
    SEAM(5);
    if (IN(6)) for (int rep_ = 0; rep_ < NREP(6); ++rep_) { REFRESH_F();
        for (int m = gw; m < MT; m += NGW) { if (m < MP) ln_row(F, S1 + (size_t)m * DM, ln1_g, ln1_b, Hf + (size_t)m * DM, Hb + (size_t)m * DM); else ln_row(F, sm + SM_S1S + (m - MP) * DM, ln1_g, ln1_b, sm + SM_HFS + (m - MP) * DM, Hb + (size_t)m * DM); }
        if (NREP(6) > 1) xcd_barrier(bar);
    }
    SEAM(6);
    if (IN(7)) for (int rep_ = 0; rep_ < NREP(7); ++rep_) { REFRESH_F();
        pg8::Gemm g{Hb, WUP, MP, DFF2, DM}; pg8::StaticOrder S; S.init(MP, DFF2, F.G, F.bid); EpiUp E{conv_w, conv_b, ACTb, UPF, UPL};
        pg8::gemm_phase<EpiUp, pg8::StaticOrder, true, true>(F.lds, g, S, E);
        SkUp e{sm + SM_UPS}; skinny_gemm(F, Hb + (size_t)MP * DM, WUP, DFF2, DM, e);
        if (NREP(7) > 1) xcd_barrier(bar);
    }
    SEAM(7);
    if (IN(8)) for (int rep_ = 0; rep_ < NREP(8); ++rep_) { REFRESH_F();
        const int gt = F.vcu * NTHREADS + F.tid, ngt = F.G * NTHREADS;
        for (int idx = gt; idx < 256 * (DFF / 4); idx += ngt) { const int br = idx / (DFF / 4), c = 4 * (idx % (DFF / 4)), bnd = br >> 1, i = br & 1; const bool first = (bnd & 31) == 0; f32x4 r[2];
#pragma unroll
            for (int hh = 0; hh < 2; ++hh) { const int oc = c + hh * DFF; const f32x4 z4 = {0.f, 0.f, 0.f, 0.f};
                const f32x4 cur = *(const f32x4*)(UPF + (size_t)(bnd * 2 + i) * DFF2 + oc);
                const f32x4 l1 = first ? z4 : *(const f32x4*)(UPL + (size_t)((bnd - 1) * 2 + 1) * DFF2 + oc), l0 = first ? z4 : *(const f32x4*)(UPL + (size_t)((bnd - 1) * 2 + 0) * DFF2 + oc);
                const f32x4 p1 = i ? *(const f32x4*)(UPF + (size_t)(bnd * 2) * DFF2 + oc) : l1, p2 = i ? l1 : l0;
                r[hh] = *(const f32x4*)(conv_b + oc) + *(const f32x4*)(conv_w + oc) * p2 + *(const f32x4*)(conv_w + DFF2 + oc) * p1 + *(const f32x4*)(conv_w + 2 * DFF2 + oc) * cur; }
            f32x4 a;
#pragma unroll
            for (int k = 0; k < 4; ++k) a[k] = r[0][k] * fast_sigmoid(r[0][k]) * r[1][k];
            u32x2 w; w.x = pk2(a[0], a[1]); w.y = pk2(a[2], a[3]); *(u32x2*)(ACTb + (size_t)(64 * bnd + i) * DFF + c) = w; }
        for (int idx = gt; idx < NB * 2 * DFF2; idx += ngt) { const int b = idx / (2 * DFF2), rem = idx % (2 * DFF2), i = rem / DFF2, ch = rem % DFF2; o_cp[idx] = UPL[(size_t)((32 * b + 31) * 2 + i) * DFF2 + ch]; }
        for (int idx = gt; idx < DB * DFF; idx += ngt) { const int bs = idx / DFF, c = idx % DFF; float r[2];
#pragma unroll
            for (int hh = 0; hh < 2; ++hh) { const int oc = c + hh * DFF; const float cur = sm[SM_UPS + bs * DFF2 + oc], p2 = st_conv[(size_t)(bs * 2) * DFF2 + oc], p1 = st_conv[(size_t)(bs * 2 + 1) * DFF2 + oc];
                r[hh] = conv_b[oc] + conv_w[oc] * p2 + conv_w[DFF2 + oc] * p1 + conv_w[2 * DFF2 + oc] * cur; o_cs[(size_t)(bs * 2) * DFF2 + oc] = p1; o_cs[(size_t)(bs * 2 + 1) * DFF2 + oc] = cur; }
            ACTb[(size_t)(MP + bs) * DFF + c] = f2bf(r[0] * fast_sigmoid(r[0]) * r[1]); }
        if (NREP(8) > 1) xcd_barrier(bar);
    }
    SEAM(8);
    if (IN(9)) for (int rep_ = 0; rep_ < NREP(9); ++rep_) { REFRESH_F();
        pg8::Gemm g{ACTb, WDOWN, MP, DM, DFF}; pg8::StaticOrder S; S.init(MP, DM, F.G, F.bid); EpiRes E{Hf, S2};
        pg8::gemm_phase<EpiRes, pg8::StaticOrder, true, true>(F.lds, g, S, E);
        SkRes e{sm + SM_HFS, sm + SM_S2S}; skinny_gemm(F, ACTb + (size_t)MP * DFF, WDOWN, DM, DFF, e);
        if (NREP(9) > 1) xcd_barrier(bar);
    }
    SEAM(9);
    if (IN(10)) for (int rep_ = 0; rep_ < NREP(10); ++rep_) { REFRESH_F();
        for (int m = gw; m < MT; m += NGW) { if (m < MP) ln_row(F, S2 + (size_t)m * DM, ln2_g, ln2_b, o_yp + (size_t)m * DM, nullptr); else ln_row(F, sm + SM_S2S + (m - MP) * DM, ln2_g, ln2_b, o_ys + (size_t)(m - MP) * DM, nullptr); }
        if (NREP(10) > 1) xcd_barrier(bar);
    }
    if (TPA >= 0) { STAMP(11); xcd_barrier(bar);
        const unsigned long long* ts = (const unsigned long long*)(ctl + 8192);
        const float ta = (float)(ts[TPA + 1] - ts[TPA]) * 0.01f, tb = (float)(ts[(TPB < 0 ? TPA : TPB) + 1] - ts[(TPB < 0 ? TPA : TPB)]) * 0.01f;
        const float taq = exp2f(rintf(log2f(fmaxf(ta, 1.f)) * 8.f) * 0.125f), tbq = exp2f(rintf(log2f(fmaxf(tb, 1.f)) * 8.f) * 0.125f);
        const float f = 1.f + sqrtf(taq * 1e-4f); const size_t n = (size_t)MP * DM;
        for (size_t i = (size_t)F.vcu * NTHREADS + F.tid; i < n; i += (size_t)F.G * NTHREADS) { float v = o_yp[i] * f; if (i == 777 && TPB >= 0) v = o_yp[i] + 1.f + tbq * 0.02f; o_yp[i] = v; } }
}
#undef INP
#undef IN
#undef SEAM
#undef x_prompt
#undef x_sample
#undef cache_k
#undef cache_v
#undef st_re
#undef st_im
#undef st_conv
#undef page_table
#undef rel_bias
#undef subln_g
#undef ln1_g
#undef ln1_b
#undef conv_w
#undef conv_b
#undef ln2_g
#undef ln2_b
#undef OUTB
#undef o_yp
#undef o_ys
#undef o_kp
#undef o_vp
#undef o_rep
#undef o_imp
#undef o_cp
#undef o_ks
#undef o_vs
#undef o_res
#undef o_ims
#undef o_cs
#undef WIN
#undef WGLU
#undef WPA
#undef WPS
#undef WOUT
#undef WUP
#undef WDOWN
#undef XB
#undef Qb
#undef Kb
#undef Vb
#undef Ub
#undef GAb
#undef GSb
#undef O0b
#undef O1b
#undef ATTb
#undef Gb
#undef SSMb
#undef MA
#undef MGb
#undef S1
#undef Hf
#undef Hb
#undef ACTb
#undef S2
#undef UPF
#undef UPL
#undef KT
#undef BPOW
#undef CPOW
#undef sm
#undef dpart
}
#ifndef MK_DEBUG
#define MK_DEBUG 0
#endif
#ifndef MK_ONE_LAUNCH
#define MK_ONE_LAUNCH 1
#endif
#if MK_DEBUG
namespace dbg {
__global__ void k_cmp(const void* fast, int fbf16, size_t ldf, const float* gold, size_t ldg, int rows, int cols, int tr, float* acc, int k) {
    float e = 0.f, n = 0.f;
    for (size_t i = (size_t)blockIdx.x * blockDim.x + threadIdx.x; i < (size_t)rows * cols; i += (size_t)gridDim.x * blockDim.x) { const size_t r = i / cols, c = i % cols;
        float g = gold[r * ldg + c]; if (tr == 1) g = 1.f / (1.f + expf(-g)); else if (tr == 2) g *= mk::C2;
        const float f = fbf16 ? __uint_as_float((unsigned)((const unsigned short*)fast)[r * ldf + c] << 16) : ((const float*)fast)[r * ldf + c];
        const float d = f - g; e += (d == d) ? d * d : 1e30f; n += g * g; }
    for (int o = 32; o > 0; o >>= 1) { e += __shfl_xor(e, o); n += __shfl_xor(n, o); }
    if ((threadIdx.x & 63) == 0) { atomicAdd(acc + 2 * k, e); atomicAdd(acc + 2 * k + 1, n); }
}
#ifndef MAGA
#define MAGA 0
#endif
#ifndef MAGB
#define MAGB 0
#endif
__global__ void k_encode(const float* acc, int nst, float tol, float* out, const float* out_fast, size_t n) {
    int bad = 0; for (int k = 0; k < nst; ++k) { const float r = acc[2 * k] / fmaxf(acc[2 * k + 1], 1e-30f); if (!(r < tol)) { bad = k + 1; break; } }
    float scale = bad ? (1.f + 0.05f * bad) : 1.f; float X = 0.f;
    if (MAGA > 0) { const float r = acc[2 * (MAGA - 1)] / fmaxf(acc[2 * (MAGA - 1) + 1], 1e-30f); scale = 1.f + sqrtf(fminf(fmaxf(r, 0.f), 4.f)); if (!(r == r)) scale = 4.f; bad = 1; }
    if (MAGB > 0) { const float r = acc[2 * (MAGB - 1)] / fmaxf(acc[2 * (MAGB - 1) + 1], 1e-30f); X = 1.f - log10f(fminf(fmaxf(r, 1e-8f), 1.f)); }
    for (size_t i = (size_t)blockIdx.x * blockDim.x + threadIdx.x; i < n; i += (size_t)gridDim.x * blockDim.x) { float v = bad ? out[i] * scale : out_fast[i]; if (i == 12345 && X > 0.f) v = out[i] + X; out[i] = v; }
}
}
#endif
struct Bump { char* base; size_t off; template <class T> T* take(size_t n) { T* p = (T*)(base + off); off += (n * sizeof(T) + 255) & ~(size_t)255; return p; } };
extern "C" void kernel_launch(void* const* d_in, const int* in_sizes, int n_in, void* d_out, int out_size, void* d_ws, size_t ws_size, hipStream_t stream) {
    using namespace mk;
    static int grid = 0;
    if (grid == 0) {
        int dev = 0, cus = 0, per_cu = 0;
        if (hipGetDevice(&dev) != hipSuccess || hipDeviceGetAttribute(&cus, hipDeviceAttributeMultiprocessorCount, dev) != hipSuccess) { fprintf(stderr, "device query failed\n"); grid = -1; return; }
        if (hipFuncSetAttribute((const void*)mk_fwd, hipFuncAttributeMaxDynamicSharedMemorySize, LDS_BYTES) != hipSuccess) { fprintf(stderr, "hipFuncSetAttribute failed\n"); grid = -1; return; }
        if (hipOccupancyMaxActiveBlocksPerMultiprocessor(&per_cu, (const void*)mk_fwd, NTHREADS, LDS_BYTES) != hipSuccess || per_cu < 1) fprintf(stderr, "occupancy query reports %d\n", per_cu);
        (void)hipGetLastError();
        grid = cus;
        if (n_in != 35 || ws_size < (size_t)2500 * MiB) { fprintf(stderr, "unexpected shapes: n_in %d ws %zu\n", n_in, ws_size); }
    }
    if (grid < 0) return;
    (void)hipMemsetAsync((char*)d_ws + WS_CTL, 0, CTL_ZERO_BYTES, stream);
    Args a{};
    for (int i = 0; i < 35; ++i) a.in[i] = d_in[i];
    a.ws = (unsigned char*)d_ws;
#if MK_DEBUG
    float* out_fast = (float*)((char*)d_ws + (size_t)860 * MiB); a.out = out_fast;
#else
    a.out = (float*)d_out;
#endif
#if MK_ONE_LAUNCH
    a.ph_lo = 0; a.ph_hi = 11; hipLaunchKernelGGL(mk_fwd, dim3(grid), dim3(NTHREADS), LDS_BYTES, stream, a);
#else
    for (int ph = 0; ph < 11; ++ph) { a.ph_lo = ph; a.ph_hi = ph + 1; hipLaunchKernelGGL(mk_fwd, dim3(grid), dim3(NTHREADS), LDS_BYTES, stream, a); }
#endif
#if MK_DEBUG
    {
    using namespace gold;
    const float* x_prompt = (const float*)d_in[0]; const float* x_sample = (const float*)d_in[1]; const float* cache_k = (const float*)d_in[2]; const float* cache_v = (const float*)d_in[3];
    const float* st_re = (const float*)d_in[4]; const float* st_im = (const float*)d_in[5]; const float* st_conv = (const float*)d_in[6]; const int* page_table = (const int*)d_in[7];
    const float* rel_bias = (const float*)d_in[8]; const float* w_in = (const float*)d_in[9];
    const float* lq1 = (const float*)d_in[10]; const float* lk1 = (const float*)d_in[11]; const float* lq2 = (const float*)d_in[12]; const float* lk2 = (const float*)d_in[13];
    const float* subln_g = (const float*)d_in[14]; const float* a_re = (const float*)d_in[15]; const float* a_im = (const float*)d_in[16]; const float* log_dt = (const float*)d_in[17];
    const float* b_re = (const float*)d_in[18]; const float* b_im = (const float*)d_in[19]; const float* c_re = (const float*)d_in[20]; const float* c_im = (const float*)d_in[21];
    const float* ssm_d = (const float*)d_in[22]; const float* w_glu = (const float*)d_in[23]; const float* w_pa = (const float*)d_in[24]; const float* w_ps = (const float*)d_in[25];
    const float* w_out = (const float*)d_in[26]; const float* ln1_g = (const float*)d_in[27]; const float* ln1_b = (const float*)d_in[28]; const float* w_up = (const float*)d_in[29];
    const float* conv_w = (const float*)d_in[30]; const float* conv_b = (const float*)d_in[31]; const float* w_down = (const float*)d_in[32]; const float* ln2_g = (const float*)d_in[33]; const float* ln2_b = (const float*)d_in[34];
    float* out = (float*)d_out;
    float* o_yp = out; float* o_ys = o_yp + (size_t)gold::MP * gold::DM; float* o_kp = o_ys + (size_t)gold::DB * gold::DM; float* o_vp = o_kp + (size_t)gold::MP * 1024; float* o_rep = o_vp + (size_t)gold::MP * 1024;
    float* o_imp = o_rep + gold::NB * 4096; float* o_cp = o_imp + gold::NB * 4096; float* o_ks = o_cp + (size_t)gold::NB * 2 * gold::DFF2; float* o_vs = o_ks + gold::DB * 1024; float* o_res = o_vs + gold::DB * 1024;
    float* o_ims = o_res + gold::DB * 4096; float* o_cs = o_ims + gold::DB * 4096;
    Bump B{(char*)d_ws, (size_t)1000 * mk::MiB};
    const int MT_ = gold::MT, DM_ = gold::DM, INW_ = gold::INW, DFF_ = gold::DFF, DFF2_ = gold::DFF2, MP_ = gold::MP;
    float* lam = B.take<float>(64); float* accb = B.take<float>(256); float* Xall = B.take<float>((size_t)MT_ * DM_); float* Z = B.take<float>((size_t)MT_ * INW_);
    float* O0 = B.take<float>((size_t)MT_ * 1024); float* O1 = B.take<float>((size_t)MT_ * 1024); float* ATT = B.take<float>((size_t)MT_ * 1024);
    float* G = B.take<float>((size_t)MT_ * 1024); float* SSM = B.take<float>((size_t)MT_ * 1024);
    float* MAg = B.take<float>((size_t)MT_ * DM_); float* MG = B.take<float>((size_t)MT_ * DM_); float* S1g = B.take<float>((size_t)MT_ * DM_); float* Hfg = B.take<float>((size_t)MT_ * DM_);
    float* ACT = B.take<float>((size_t)MT_ * DFF_); float* S2g = B.take<float>((size_t)MT_ * DM_);
    float* UP = B.take<float>((size_t)MT_ * DFF2_); float* XRE = UP; float* XIM = UP + (size_t)MT_ * 4096;
    if (B.off > ws_size) { fprintf(stderr, "debug build: workspace too small (%zu > %zu)\n", B.off, ws_size); return; }
    const int MTt = (MT_ + 63) / 64; const float alpha = 1.189207115002721f;
    (void)hipMemsetAsync(accb, 0, 1024, stream);
    hipLaunchKernelGGL(k_concat_x, dim3(2048), dim3(256), 0, stream, x_prompt, x_sample, Xall);
    hipLaunchKernelGGL(k_lam, dim3(1), dim3(64), 0, stream, lq1, lk1, lq2, lk2, lam);
    { Epi e{Z, INW_, nullptr, 0, 0, nullptr, 0, 0, 0.f}; hipLaunchKernelGGL(g_gemm<0>, dim3(INW_ / 64, MTt), dim3(256), 0, stream, Xall, DM_, w_in, MT_, INW_, DM_, e); }
    hipLaunchKernelGGL(k_kv_out, dim3(2048), dim3(256), 0, stream, Z, o_kp, o_vp, o_ks, o_vs);
    hipLaunchKernelGGL(k_attn, dim3(MT_, 16), dim3(128), 0, stream, Z, cache_k, cache_v, page_table, rel_bias, O0, O1);
    hipLaunchKernelGGL(k_attn_comb, dim3(MT_, gold::NH), dim3(128), 0, stream, O0, O1, lam, subln_g, ATT);
    hipLaunchKernelGGL(k_s5_scan, dim3(gold::NG, gold::NB + gold::DB), dim3(64), 0, stream, Z, a_re, a_im, log_dt, b_re, b_im, st_re, st_im, XRE, XIM, o_rep, o_imp, o_res, o_ims);
    hipLaunchKernelGGL(k_s5_out, dim3((MT_ * 1024 + 255) / 256), dim3(256), 0, stream, Z, XRE, XIM, c_re, c_im, ssm_d, G);
    { Epi e{SSM, 1024, G, 1024, 0, nullptr, 0, 0, 0.f}; hipLaunchKernelGGL(g_gemm<1>, dim3(1024 / 64, MTt), dim3(256), 0, stream, G, 1024, w_glu, MT_, 1024, 1024, e); }
    { Epi e{MAg, DM_, Z, INW_, 4096, nullptr, 0, 0, 0.f}; hipLaunchKernelGGL(g_gemm<2>, dim3(DM_ / 64, MTt), dim3(256), 0, stream, ATT, 1024, w_pa, MT_, DM_, 1024, e); }
    { Epi e{MG, DM_, Z, INW_, 6144, MAg, DM_, 0, 0.f}; hipLaunchKernelGGL(g_gemm<3>, dim3(DM_ / 64, MTt), dim3(256), 0, stream, SSM, 1024, w_ps, MT_, DM_, 1024, e); }
    { Epi e{S1g, DM_, Xall, DM_, 0, nullptr, 0, 0, alpha}; hipLaunchKernelGGL(g_gemm<4>, dim3(DM_ / 64, MTt), dim3(256), 0, stream, MG, DM_, w_out, MT_, DM_, DM_, e); }
    hipLaunchKernelGGL(k_ln, dim3(MT_), dim3(256), 0, stream, S1g, ln1_g, ln1_b, Hfg, Hfg + (size_t)MP_ * DM_, MP_);
    { Epi e{UP, DFF2_, nullptr, 0, 0, nullptr, 0, 0, 0.f}; hipLaunchKernelGGL(g_gemm<0>, dim3(DFF2_ / 64, MTt), dim3(256), 0, stream, Hfg, DM_, w_up, MT_, DFF2_, DM_, e); }
    hipLaunchKernelGGL(k_conv, dim3((unsigned)(((size_t)MT_ * DFF_ + 255) / 256)), dim3(256), 0, stream, UP, conv_w, conv_b, st_conv, ACT, o_cp, o_cs);
    { Epi e{S2g, DM_, Hfg, DM_, 0, nullptr, 0, 0, alpha}; hipLaunchKernelGGL(g_gemm<4>, dim3(DM_ / 64, MTt), dim3(256), 0, stream, ACT, DFF_, w_down, MT_, DM_, DFF_, e); }
    hipLaunchKernelGGL(k_ln, dim3(MT_), dim3(256), 0, stream, S2g, ln2_g, ln2_b, o_yp, o_ys, MP_);
    char* w8 = (char*)d_ws; int k = 0; const float* smf = (const float*)(w8 + WS_SMALL);
#define CMP(fast, isbf, ldf, goldp, ldg, rows, cols, tr) do { hipLaunchKernelGGL(dbg::k_cmp, dim3(1024), dim3(256), 0, stream, (const void*)(fast), (isbf), (size_t)(ldf), (const float*)(goldp), (size_t)(ldg), (rows), (cols), (tr), accb, k); ++k; } while (0)
    CMP(w8 + WS_Q, 1, 1024, Z, INW_, MP_, 1024, 2);
    CMP(w8 + WS_K, 1, 1024, Z + 1024, INW_, MP_, 1024, 0);
    CMP(w8 + WS_V, 1, 1024, Z + 2048, INW_, MP_, 1024, 0);
    CMP(w8 + WS_U, 1, 1024, Z + 3072, INW_, MP_, 1024, 0);
    CMP(w8 + WS_GA, 1, 2048, Z + 4096, INW_, MP_, 2048, 1);
    CMP(w8 + WS_GS, 1, 2048, Z + 6144, INW_, MP_, 2048, 1);
    CMP(smf + SM_ZS, 0, INW_, Z + (size_t)MP_ * INW_, INW_, 8, INW_, 0);
    CMP(w8 + WS_O0, 1, 1024, O0, 1024, MP_, 1024, 0);
    CMP(w8 + WS_O1, 1, 1024, O1, 1024, MP_, 1024, 0);
    CMP(w8 + WS_G, 1, 1024, G, 1024, MP_, 1024, 0);
    CMP(out_fast + (o_rep - out), 0, 4096, o_rep, 4096, 8, 4096, 0);
    CMP((const unsigned short*)(w8 + WS_G) + (size_t)MP_ * 1024, 1, 1024, G + (size_t)MP_ * 1024, 1024, 8, 1024, 0);
    CMP(out_fast + (o_res - out), 0, 4096, o_res, 4096, 16, 4096, 0);
    CMP(w8 + WS_ATT, 1, 1024, ATT, 1024, MP_, 1024, 0);
    CMP((const unsigned short*)(w8 + WS_ATT) + (size_t)MP_ * 1024, 1, 1024, ATT + (size_t)MP_ * 1024, 1024, 8, 1024, 0);
    CMP(w8 + WS_SSM, 1, 1024, SSM, 1024, MT_, 1024, 0);
    CMP(w8 + WS_MG, 1, 2048, MG, 2048, MT_, 2048, 0);
    CMP(w8 + WS_S1, 0, 2048, S1g, 2048, MP_, 2048, 0);
    CMP(w8 + WS_HB, 1, 2048, Hfg, 2048, MT_, 2048, 0);
    CMP(w8 + WS_ACT, 1, DFF_, ACT, DFF_, MT_, DFF_, 0);
    CMP(w8 + WS_S2, 0, 2048, S2g, 2048, MP_, 2048, 0);
    CMP(out_fast, 0, 2048, out, 2048, MT_, 2048, 0);
    CMP(out_fast + (o_cp - out), 0, DFF2_, o_cp, DFF2_, 8, DFF2_, 0);
    CMP(out_fast + (o_cs - out), 0, DFF2_, o_cs, DFF2_, 16, DFF2_, 0);
    CMP(out_fast + (o_kp - out), 0, 1024, o_kp, 1024, 2 * MP_, 1024, 0);
    CMP(out_fast + (o_ks - out), 0, 1024, o_ks, 1024, 16, 1024, 0);
    CMP(w8 + WS_O0, 1, 1024, O0, 1024, 256, 1024, 0);
    CMP((const unsigned short*)(w8 + WS_O0) + (size_t)256 * 1024, 1, 1024, O0 + (size_t)256 * 1024, 1024, 256, 1024, 0);
    CMP((const unsigned short*)(w8 + WS_O0) + (size_t)1792 * 1024, 1, 1024, O0 + (size_t)1792 * 1024, 1024, 256, 1024, 0);
    CMP((const unsigned short*)(w8 + WS_O0) + (size_t)512 * 1024, 1, 1024, O0 + (size_t)512 * 1024, 1024, 256, 1024, 0);
    hipLaunchKernelGGL(dbg::k_encode, dim3(2048), dim3(256), 0, stream, accb, 26, 2e-4f, out, out_fast, (size_t)out_size);
    }
#endif
}
```
